# Optimizing an MI355X kernel written in HIP

```python
import jax, jax.numpy as jnp
from jax import lax
import numpy as np

D_MODEL = 1024
BATCH = 4
SEQ = 4096
DEPTH = 2

HEAD_DIM = 64
N_HEADS = D_MODEL // HEAD_DIM
N_HEADS_A = N_HEADS // 2
N_HEADS_B = N_HEADS - N_HEADS_A
WIDTH_A = N_HEADS_A * HEAD_DIM
WIDTH_B = N_HEADS_B * HEAD_DIM
CHUNK = 128
Q_BLOCK = 128
CONV_WIDTH = 3
CONV_DIM = D_MODEL
D_FF = ((8 * D_MODEL // 3 + 127) // 128) * 128
MACARON_WEIGHT = 0.5
N_SUB = 3
N_EVEN = (DEPTH + 1) // 2
N_ODD = DEPTH // 2
EPS = 1e-6

kernel_name = "hybrid_gmlp_stickbreak_shortconv_macaron_adaln"


def rms_norm(x, g):
    xf = x.astype(jnp.float32)
    y = xf * lax.rsqrt(jnp.mean(xf * xf, axis=-1, keepdims=True) + EPS)
    return (y * g.astype(jnp.float32)).astype(x.dtype)


def modulate(x, g, shift, scale):
    return rms_norm(x, g) * (1 + scale[:, None, :]) + shift[:, None, :]


def swiglu(h, w_gate, w_up, w_down):
    return (jax.nn.silu(h @ w_gate) * (h @ w_up)) @ w_down


def stick_breaking_attention(q, k, v):
    S = q.shape[1]
    scale = HEAD_DIM ** -0.5
    outs = []
    for blk in range(S // Q_BLOCK):
        q0 = blk * Q_BLOCK
        kv_len = q0 + Q_BLOCK
        qb = q[:, q0:kv_len].astype(jnp.float32)
        kb = k[:, :kv_len].astype(jnp.float32)
        z = jnp.einsum('bqhd,bkhd->bhqk', qb, kb) * scale
        t_pos = q0 + jnp.arange(Q_BLOCK)[:, None]
        s_pos = jnp.arange(kv_len)[None, :]
        before = s_pos < t_pos
        log_1mb = jnp.where(before, -jax.nn.softplus(z), 0.0)
        tail = lax.cumsum(log_1mb, axis=3, reverse=True) - log_1mb
        w = jnp.where(before, jnp.exp(jax.nn.log_sigmoid(z) + tail), 0.0)
        outs.append(jnp.einsum('bhqk,bkhd->bqhd', w.astype(v.dtype), v[:, :kv_len]))
    return jnp.concatenate(outs, axis=1)


def gmlp_stickbreak_mixer(h, w_in, vnorm_g, w_s, b_s, w_out):
    Bsz, S, _ = h.shape
    proj = h @ w_in
    uv_a, qkv_b = proj[..., :2 * WIDTH_A], proj[..., 2 * WIDTH_A:]
    u, v = jnp.split(jax.nn.gelu(uv_a, approximate=False), 2, axis=-1)
    u = u.reshape(Bsz, S, N_HEADS_A, HEAD_DIM)
    v = rms_norm(v.reshape(Bsz, S, N_HEADS_A, HEAD_DIM), vnorm_g.reshape(N_HEADS_A, HEAD_DIM))
    v = v.reshape(Bsz, S // CHUNK, CHUNK, N_HEADS_A, HEAD_DIM)
    w_causal = jnp.tril(w_s)
    sv = jnp.einsum('hts,bnshd->bnthd', w_causal, v) + b_s.T[:, :, None]
    y_a = u * sv.reshape(Bsz, S, N_HEADS_A, HEAD_DIM)
    q, k, vb = jnp.split(qkv_b, 3, axis=-1)
    q = q.reshape(Bsz, S, N_HEADS_B, HEAD_DIM)
    k = k.reshape(Bsz, S, N_HEADS_B, HEAD_DIM)
    vb = vb.reshape(Bsz, S, N_HEADS_B, HEAD_DIM)
    y_b = stick_breaking_attention(q, k, vb)
    y = jnp.concatenate([y_a.reshape(Bsz, S, WIDTH_A), y_b.reshape(Bsz, S, WIDTH_B)], axis=-1)
    return y @ w_out


def short_conv_mixer(h, w_in, conv_w, w_out):
    b_gate, c_gate, xs = jnp.split(h @ w_in, 3, axis=-1)
    y = lax.conv_general_dilated(
        c_gate * xs, conv_w[:, None, :].astype(xs.dtype),
        window_strides=(1,), padding=((CONV_WIDTH - 1, 0),),
        dimension_numbers=('NWC', 'WIO', 'NWC'), feature_group_count=CONV_DIM)
    return (b_gate * y) @ w_out


def setup_inputs(seed: int = 0) -> dict:
    key = jax.random.key(seed)
    ks = jax.random.split(key, 18)
    f32 = jnp.float32
    D = D_MODEL

    def nrm(k, shape, fan_in):
        return jax.random.normal(k, shape, f32) * (fan_in ** -0.5)

    return {
        "x": jax.random.normal(ks[0], (BATCH, SEQ, D), f32),
        "c": jax.random.normal(ks[1], (BATCH, D), f32),
        "mod_w": nrm(ks[2], (DEPTH, D, 3 * N_SUB * D), D) * 0.5,
        "mod_b": 0.02 * jax.random.normal(ks[3], (DEPTH, 3 * N_SUB * D), f32),
        "norm_g": 1.0 + 0.02 * jax.random.normal(ks[4], (DEPTH, N_SUB, D), f32),
        "ffn_w_gate": nrm(ks[5], (DEPTH, 2, D, D_FF), D),
        "ffn_w_up": nrm(ks[6], (DEPTH, 2, D, D_FF), D),
        "ffn_w_down": nrm(ks[7], (DEPTH, 2, D_FF, D), D_FF),
        "hy_w_in": nrm(ks[8], (N_EVEN, D, 2 * WIDTH_A + 3 * WIDTH_B), D),
        "hy_w_out": nrm(ks[9], (N_EVEN, WIDTH_A + WIDTH_B, D), WIDTH_A + WIDTH_B),
        "gm_vnorm_g": 1.0 + 0.02 * jax.random.normal(ks[10], (N_EVEN, WIDTH_A), f32),
        "gm_w_s": nrm(ks[11], (N_EVEN, N_HEADS_A, CHUNK, CHUNK), CHUNK),
        "gm_b_s": 1.0 + 0.02 * jax.random.normal(ks[12], (N_EVEN, N_HEADS_A, CHUNK), f32),
        "sc_w_in": nrm(ks[13], (N_ODD, D, 3 * CONV_DIM), D),
        "sc_conv_w": nrm(ks[14], (N_ODD, CONV_WIDTH, CONV_DIM), CONV_WIDTH),
        "sc_w_out": nrm(ks[15], (N_ODD, CONV_DIM, D), CONV_DIM),
        "final_norm_g": 1.0 + 0.02 * jax.random.normal(ks[16], (D,), f32),
    }


def reference(x, c, mod_w, mod_b, norm_g, ffn_w_gate, ffn_w_up, ffn_w_down,
              hy_w_in, hy_w_out, gm_vnorm_g, gm_w_s, gm_b_s,
              sc_w_in, sc_conv_w, sc_w_out, final_norm_g):
    cond = jax.nn.silu(c)
    for layer in range(DEPTH):
        mod = cond @ mod_w[layer] + mod_b[layer]
        sh1, sc1, g1, sh2, sc2, g2, sh3, sc3, g3 = jnp.split(mod, 3 * N_SUB, axis=-1)
        h = modulate(x, norm_g[layer, 0], sh1, sc1)
        x = x + MACARON_WEIGHT * g1[:, None, :] * swiglu(
            h, ffn_w_gate[layer, 0], ffn_w_up[layer, 0], ffn_w_down[layer, 0])
        h = modulate(x, norm_g[layer, 1], sh2, sc2)
        i = layer // 2
        if layer % 2 == 0:
            m = gmlp_stickbreak_mixer(h, hy_w_in[i], gm_vnorm_g[i], gm_w_s[i], gm_b_s[i], hy_w_out[i])
        else:
            m = short_conv_mixer(h, sc_w_in[i], sc_conv_w[i], sc_w_out[i])
        x = x + g2[:, None, :] * m
        h = modulate(x, norm_g[layer, 2], sh3, sc3)
        x = x + MACARON_WEIGHT * g3[:, None, :] * swiglu(
            h, ffn_w_gate[layer, 1], ffn_w_up[layer, 1], ffn_w_down[layer, 1])
    return rms_norm(x, final_norm_g)
```

```cpp
#include <hip/hip_runtime.h>
#include <hip/hip_cooperative_groups.h>
#include <cstdio>
#include <cstdint>
namespace cg = cooperative_groups;
namespace pg8 {
#define PG8_LAS __attribute__((address_space(3)))
typedef unsigned short bf16_t;
typedef short bf16x8 __attribute__((ext_vector_type(8)));
typedef float f32x4 __attribute__((ext_vector_type(4)));
typedef unsigned u32x4 __attribute__((ext_vector_type(4)));
constexpr int BM = 256, BK = 64, HALF = 128, HTB = HALF * BK * 2  , STAGE_BYTES = 8 * HTB, NXCD = 8, WGM = 8;

__host__ __device__ __forceinline__ int lds_byte(int r, int c) { const int st = (r >> 4) * 2 + (c >> 5), rr = r & 15, cc = c & 31, ob = rr * 64 + cc * 2; return st * 1024 + (ob ^ (((ob >> 9) & 1) << 5)); }
__host__ __device__ __forceinline__ void stage_rc(int b, int& R, int& C) { const int st = b / 1024, sb = b % 1024, swz = sb ^ (((sb >> 9) & 1) << 5); R = (st >> 1) * 16 + swz / 64; C = (st & 1) * 32 + (swz % 64) / 2; }
__host__ __device__ __forceinline__ int perm32(int rho) { const int n = rho >> 4, i = rho & 15; return 8 * (i >> 2) + 4 * n + (i & 3); }

struct Unit { int pm, pn; };
struct Gemm { const bf16_t* A; const bf16_t* Bt; int M, N, K; };

struct StaticOrder {
    int nM, nN, nwg, G, c;
    __host__ __device__ void init(int M, int N, int G_, int c_) { nM = M / BM; nN = N / BM; nwg = nM * nN; G = G_; c = c_; }
    __host__ __device__ bool next(int i, Unit& u) const {
        const long L = (long)i * G + c; if (L >= nwg) return false;
        int wgid = (int)L; { const int q = nwg / NXCD, r = nwg % NXCD, xcd = wgid % NXCD, off = wgid / NXCD; wgid = (xcd < r ? xcd * (q + 1) : r * (q + 1) + (xcd - r) * q) + off; }
        const int nig = WGM * nN, gid = wgid / nig, fm = gid * WGM, gsz = (nM - fm) < WGM ? (nM - fm) : WGM;
        u.pm = fm + ((wgid % nig) % gsz); u.pn = (wgid % nig) / gsz; return true;
    }
    __device__ __forceinline__ void a_ready(const Unit&) const {}
    __device__ __forceinline__ void done(const Unit&) const {}
};

__device__ __forceinline__ unsigned cvt_pk_bf16(float lo, float hi) { unsigned r; asm volatile("v_cvt_pk_bf16_f32 %0, %1, %2" : "=v"(r) : "v"(lo), "v"(hi)); return r; }
typedef float f32x2 __attribute__((ext_vector_type(2)));
__device__ __forceinline__ f32x2 gelu_pk(f32x2 v) {
    const f32x2 av = __builtin_elementwise_abs(v), d = av * 0.2316418882f + 1.0f;
    f32x2 t; t.x = __builtin_amdgcn_rcpf(d.x); t.y = __builtin_amdgcn_rcpf(d.y);
    f32x2 q = t * 0.5307027145f + (-0.7265760135f); q = q * t + 0.7107068705f; q = q * t + (-0.142248368f); q = q * t + 0.127414796f; q = q * t;
    const f32x2 s = (v * v) * (-0.72134752044f);
    f32x2 e; e.x = __builtin_amdgcn_exp2f(s.x); e.y = __builtin_amdgcn_exp2f(s.y);
    const f32x2 m = v * (q * e), r = v - m;
    f32x2 o; o.x = v.x < 0.f ? m.x : r.x; o.y = v.y < 0.f ? m.y : r.y; return o;
}

__device__ __forceinline__ float silu_f(float g) { return g * __builtin_amdgcn_rcpf(1.0f + __builtin_amdgcn_exp2f(-1.44269504f * g)); }
__device__ __forceinline__ float rstd_of(float ssq) { return __builtin_amdgcn_rsqf(ssq * (1.0f / 1024.0f) + 1e-6f); }
struct EpiSwiGLU {
    static constexpr bool PERM = true, AFTER_DRAIN = false;
    bf16_t* O; int ldc; const float* ssq; const float* bias;
    __device__ __forceinline__ void operator()(const f32x4 (&acc)[2][2][4][2], const Unit& u, int wr, int wc, int fr, int fq) const {
        const int row0 = u.pm * BM + wr * 64 + fr, col0 = u.pn * HALF + wc * 32 + 8 * fq;
        const float* bp = bias + (size_t)((u.pm * BM) >> 12) * 5632 + u.pn * BM + wc * 32 + 8 * fq;
        const f32x4 bg0 = *(const f32x4*)bp, bg1 = *(const f32x4*)(bp + 4), bu0 = *(const f32x4*)(bp + HALF), bu1 = *(const f32x4*)(bp + HALF + 4);
        float sq8[2][4];
#pragma unroll
        for (int ai = 0; ai < 2; ++ai)
#pragma unroll
            for (int m = 0; m < 4; ++m) sq8[ai][m] = ssq[row0 + ai * HALF + m * 16];
#pragma unroll
        for (int ai = 0; ai < 2; ++ai)
#pragma unroll
            for (int m = 0; m < 4; ++m) { const int row = row0 + ai * HALF + m * 16; bf16_t* rowp = O + (size_t)row * ldc + col0;
                const float rs = rstd_of(sq8[ai][m]);
                const f32x4 g0 = acc[ai][0][m][0] * rs + bg0, g1 = acc[ai][0][m][1] * rs + bg1, u0 = acc[ai][1][m][0] * rs + bu0, u1 = acc[ai][1][m][1] * rs + bu1;
                u32x4 w; w.x = cvt_pk_bf16(silu_f(g0[0]) * u0[0], silu_f(g0[1]) * u0[1]); w.y = cvt_pk_bf16(silu_f(g0[2]) * u0[2], silu_f(g0[3]) * u0[3]);
                w.z = cvt_pk_bf16(silu_f(g1[0]) * u1[0], silu_f(g1[1]) * u1[1]); w.w = cvt_pk_bf16(silu_f(g1[2]) * u1[2], silu_f(g1[3]) * u1[3]);
                *(u32x4*)rowp = w; }
    }
};
template <bool TR> struct EpiBf16G {
    static constexpr bool PERM = true, AFTER_DRAIN = false;
    bf16_t* O; int ldc; int gelu_tiles; const float* ssq; const float* bias; int bpitch;
    __device__ __forceinline__ void operator()(const f32x4 (&acc)[2][2][4][2], const Unit& u, int wr, int wc, int fr, int fq) const {
        const int row0 = u.pm * BM + wr * 64 + fr, col0 = u.pn * BM + wc * 32 + 8 * fq; const bool ge = u.pn < gelu_tiles, qs = gelu_tiles != 0 && (u.pn == 4 || u.pn == 5);
        f32x4 cv[2][2];
        const float* bp = bias + (size_t)(((TR ? u.pn : u.pm) * BM) >> 12) * bpitch;
#pragma unroll
        for (int bj = 0; bj < 2; ++bj)
#pragma unroll
            for (int n = 0; n < 2; ++n) {
                if (TR) { const f32x4 q = *(const f32x4*)(ssq + col0 + bj * HALF + 4 * n); cv[bj][n] = (f32x4){rstd_of(q[0]), rstd_of(q[1]), rstd_of(q[2]), rstd_of(q[3])}; }
                else cv[bj][n] = *(const f32x4*)(bp + col0 + bj * HALF + 4 * n);
            }
        float rv8[2][4];
#pragma unroll
        for (int ai = 0; ai < 2; ++ai)
#pragma unroll
            for (int m = 0; m < 4; ++m) { const int row = row0 + ai * HALF + m * 16; rv8[ai][m] = TR ? bp[row] : ssq[row]; }
#pragma unroll
        for (int ai = 0; ai < 2; ++ai)
#pragma unroll
            for (int m = 0; m < 4; ++m) { const int row = row0 + ai * HALF + m * 16; bf16_t* rowp = O + (size_t)row * ldc + col0;
                const float rv = TR ? rv8[ai][m] : rstd_of(rv8[ai][m]);
#pragma unroll
                for (int bj = 0; bj < 2; ++bj) { f32x4 v0, v1;
                    if (TR) { v0 = acc[ai][bj][m][0] * cv[bj][0] + rv; v1 = acc[ai][bj][m][1] * cv[bj][1] + rv; }
                    else { v0 = acc[ai][bj][m][0] * rv + cv[bj][0]; v1 = acc[ai][bj][m][1] * rv + cv[bj][1]; }
                    if (ge) { f32x2 a = gelu_pk((f32x2){v0[0], v0[1]}), b = gelu_pk((f32x2){v0[2], v0[3]}), c = gelu_pk((f32x2){v1[0], v1[1]}), d = gelu_pk((f32x2){v1[2], v1[3]});
                        v0 = (f32x4){a.x, a.y, b.x, b.y}; v1 = (f32x4){c.x, c.y, d.x, d.y}; }
                    if (!TR && qs) { v0 = v0 * (-0.125f * 1.44269504f); v1 = v1 * (-0.125f * 1.44269504f); }
                    u32x4 w; w.x = cvt_pk_bf16(v0[0], v0[1]); w.y = cvt_pk_bf16(v0[2], v0[3]); w.z = cvt_pk_bf16(v1[0], v1[1]); w.w = cvt_pk_bf16(v1[2], v1[3]);
                    *(u32x4*)(rowp + bj * HALF) = w; } }
    }
};
struct EpiResid {
    static constexpr bool PERM = true, AFTER_DRAIN = false;
    const bf16_t* xin; bf16_t* xout; const float* mod; int goff, soff; bf16_t* XS; const float* gn; float* ssq;
    template <int AI, int M0> __device__ __forceinline__ void ld(u32x4 (&r)[2][2], int row0, int col0) const {
#pragma unroll
        for (int m = 0; m < 2; ++m)
#pragma unroll
            for (int bj = 0; bj < 2; ++bj) r[m][bj] = *(const u32x4*)(xin + (size_t)(row0 + AI * HALF + (M0 + m) * 16) * 1024 + col0 + bj * HALF);
    }
    template <int AI, int M0> __device__ __forceinline__ void cp(f32x4 (&y)[2][2][2], const u32x4 (&r)[2][2], const f32x4 (&acc)[2][2][4][2], const f32x4 (&gv)[2][2]) const {
#pragma unroll
        for (int m = 0; m < 2; ++m)
#pragma unroll
            for (int bj = 0; bj < 2; ++bj) { const u32x4 q = r[m][bj];
                const f32x4 x0 = {__uint_as_float(q.x << 16), __uint_as_float(q.x & 0xffff0000u), __uint_as_float(q.y << 16), __uint_as_float(q.y & 0xffff0000u)};
                const f32x4 x1 = {__uint_as_float(q.z << 16), __uint_as_float(q.z & 0xffff0000u), __uint_as_float(q.w << 16), __uint_as_float(q.w & 0xffff0000u)};
                y[m][bj][0] = x0 + gv[bj][0] * acc[AI][bj][M0 + m][0]; y[m][bj][1] = x1 + gv[bj][1] * acc[AI][bj][M0 + m][1]; }
    }
    template <int AI, int M0> __device__ __forceinline__ void st(const f32x4 (&y)[2][2][2], const f32x4 (&gs)[2][2], int row0, int col0, int fq) const {
#pragma unroll
        for (int m = 0; m < 2; ++m) { const int row = row0 + AI * HALF + (M0 + m) * 16; float sq = 0.f;
#pragma unroll
            for (int bj = 0; bj < 2; ++bj) { const size_t off = (size_t)row * 1024 + col0 + bj * HALF; const f32x4 y0 = y[m][bj][0], y1 = y[m][bj][1];
                u32x4 xw; xw.x = cvt_pk_bf16(y0[0], y0[1]); xw.y = cvt_pk_bf16(y0[2], y0[3]); xw.z = cvt_pk_bf16(y1[0], y1[1]); xw.w = cvt_pk_bf16(y1[2], y1[3]);
                *(u32x4*)(xout + off) = xw;
                sq += (y0[0] * y0[0] + y0[1] * y0[1]) + (y0[2] * y0[2] + y0[3] * y0[3]) + (y1[0] * y1[0] + y1[1] * y1[1]) + (y1[2] * y1[2] + y1[3] * y1[3]);
                const f32x4 s0 = y0 * gs[bj][0], s1 = y1 * gs[bj][1];
                u32x4 w; w.x = cvt_pk_bf16(s0[0], s0[1]); w.y = cvt_pk_bf16(s0[2], s0[3]); w.z = cvt_pk_bf16(s1[0], s1[1]); w.w = cvt_pk_bf16(s1[2], s1[3]);
                *(u32x4*)(XS + off) = w; }
            sq += __shfl_xor(sq, 16); sq += __shfl_xor(sq, 32);
            if (fq == 0) (void)__hip_atomic_fetch_add(ssq + row, sq, __ATOMIC_RELAXED, __HIP_MEMORY_SCOPE_AGENT); }
    }
    __device__ __forceinline__ void operator()(const f32x4 (&acc)[2][2][4][2], const Unit& u, int wr, int wc, int fr, int fq) const {
        const int row0 = u.pm * BM + wr * 64 + fr, col0 = u.pn * BM + wc * 32 + 8 * fq; const float* mb = mod + (size_t)((u.pm * BM) >> 12) * 9216 + col0;
        u32x4 ra[2][2], rb[2][2]; f32x4 y[2][2][2];
        ld<0, 0>(ra, row0, col0);
        f32x4 gv[2][2], gs[2][2];
#pragma unroll
        for (int bj = 0; bj < 2; ++bj)
#pragma unroll
            for (int n = 0; n < 2; ++n) { gv[bj][n] = *(const f32x4*)(mb + goff + bj * HALF + 4 * n);
                gs[bj][n] = *(const f32x4*)(gn + col0 + bj * HALF + 4 * n) * (*(const f32x4*)(mb + soff + bj * HALF + 4 * n) + 1.0f); }
        cp<0, 0>(y, ra, acc, gv); ld<0, 2>(rb, row0, col0); st<0, 0>(y, gs, row0, col0, fq);
        cp<0, 2>(y, rb, acc, gv); ld<1, 0>(ra, row0, col0); st<0, 2>(y, gs, row0, col0, fq);
        cp<1, 0>(y, ra, acc, gv); ld<1, 2>(rb, row0, col0); st<1, 0>(y, gs, row0, col0, fq);
        cp<1, 2>(y, rb, acc, gv); st<1, 2>(y, gs, row0, col0, fq);
    }
};

template <class Epi, class Sched, bool ALIGN_EPI = false, bool SP2 = false>
__device__ __forceinline__ void gemm_phase(PG8_LAS unsigned char* lds, const Gemm g, const Sched& S, const Epi& E) {
    int tid_ = threadIdx.x; asm volatile("" : "+v"(tid_)); const int tid = tid_, wid = __builtin_amdgcn_readfirstlane(tid >> 6), lane = tid & 63, wr = wid >> 2, wc = wid & 3, fr = lane & 15, fq = lane >> 4;
    const int K = g.K, nt = K / BK;
    unsigned voffA[2], voffB[2];
#pragma unroll
    for (int i = 0; i < 2; ++i) { int R, C; stage_rc(tid * 16 + i * 8192, R, C); const int Rb = Epi::PERM ? ((R & ~31) + perm32(R & 31)) : R;
        voffA[i] = (unsigned)(R * K + C) * 2u; voffB[i] = (unsigned)(Rb * K + C) * 2u; }
    const size_t kstep = (size_t)(BK * 2);
    const size_t hstep = (size_t)HALF * K * 2;
    const size_t tstep = 2 * hstep;
    const unsigned ldsw = (unsigned)wid * 1024u;
    const int aoff = lds_byte(wr * 64 + fr, fq * 8), boff = lds_byte(wc * 32 + fr, fq * 8);
#define PG8_SA(b, h) (((b) * 2 + (h)) * HTB)
#define PG8_SB(b, h) ((4 + (b) * 2 + (h)) * HTB)
#define PG8_STAGE(bufoff, gbase, voff) do { _Pragma("unroll") for (int _i = 0; _i < 2; ++_i) \
        __builtin_amdgcn_global_load_lds((const unsigned*)((const char*)(gbase) + (voff)[_i]), (PG8_LAS unsigned*)(lds + (bufoff) + ldsw + _i * 8192), 16, 0, 0); } while (0)
#define PG8_LDA(dst, b, h) do { _Pragma("unroll") for (int m = 0; m < 4; ++m) _Pragma("unroll") for (int k = 0; k < 2; ++k) dst[m][k] = *(const PG8_LAS bf16x8*)(lds + PG8_SA(b, h) + aoff + m * 2048 + k * 1024); } while (0)
#define PG8_LDB(dst, b, h) do { _Pragma("unroll") for (int n = 0; n < 2; ++n) _Pragma("unroll") for (int k = 0; k < 2; ++k) dst[n][k] = *(const PG8_LAS bf16x8*)(lds + PG8_SB(b, h) + boff + n * 2048 + k * 1024); } while (0)
#define PG8_MMA(ai, bj, At, Bt) do { __builtin_amdgcn_s_setprio(1); _Pragma("unroll") for (int m = 0; m < 4; ++m) _Pragma("unroll") for (int n = 0; n < 2; ++n) _Pragma("unroll") for (int k = 0; k < 2; ++k) \
        acc[ai][bj][m][n] = __builtin_amdgcn_mfma_f32_16x16x32_bf16(Bt[n][k], At[m][k], acc[ai][bj][m][n], 0, 0, 0); __builtin_amdgcn_s_setprio(0); } while (0)
#define PG8_WAIT_V(n) asm volatile("s_waitcnt vmcnt(" #n ")" ::: "memory")
#define PG8_WAIT_L(n) asm volatile("s_waitcnt lgkmcnt(" #n ")" ::: "memory")
#define PG8_BAR __builtin_amdgcn_s_barrier()
#define PG8_SCHED __builtin_amdgcn_sched_barrier(0)
    Unit cur, nxt; int ui = 0;
    if (!S.next(0, cur)) return;
    f32x4 acc[2][2][4][2];
#pragma unroll
    for (int a = 0; a < 2; ++a)
#pragma unroll
        for (int b = 0; b < 2; ++b)
#pragma unroll
            for (int m = 0; m < 4; ++m)
#pragma unroll
                for (int n = 0; n < 2; ++n) acc[a][b][m][n] = (f32x4){0.f, 0.f, 0.f, 0.f};
    bf16x8 At[4][2], B0[2][2], B1[2][2];
    const char* cA = (const char*)g.A + (size_t)cur.pm * tstep; const char* cB = (const char*)g.Bt + (size_t)cur.pn * tstep;
    S.a_ready(cur);
    if constexpr (SP2) {
        PG8_STAGE(PG8_SB(0, 0), cB, voffB); PG8_STAGE(PG8_SB(0, 1), cB + hstep, voffB); PG8_STAGE(PG8_SA(0, 0), cA, voffA); PG8_STAGE(PG8_SA(0, 1), cA + hstep, voffA);
        if (wr == 1) PG8_BAR;
        PG8_WAIT_V(2); PG8_BAR;
        PG8_STAGE(PG8_SB(1, 0), cB + kstep, voffB); PG8_STAGE(PG8_SA(1, 0), cA + kstep, voffA); PG8_STAGE(PG8_SB(1, 1), cB + hstep + kstep, voffB);
        PG8_WAIT_V(6); PG8_BAR;
    } else {
        PG8_STAGE(PG8_SB(0, 0), cB, voffB); PG8_STAGE(PG8_SA(0, 0), cA, voffA); PG8_STAGE(PG8_SB(0, 1), cB + hstep, voffB); PG8_STAGE(PG8_SA(0, 1), cA + hstep, voffA);
        if (wr == 1) PG8_BAR;
        PG8_WAIT_V(4); PG8_BAR;
        PG8_STAGE(PG8_SB(1, 0), cB + kstep, voffB); PG8_STAGE(PG8_SA(1, 0), cA + kstep, voffA); PG8_STAGE(PG8_SB(1, 1), cB + hstep + kstep, voffB);
        PG8_WAIT_V(6); PG8_BAR;
    }
    for (;;) {
        const bool has_next = S.next(ui + 1, nxt);
        const char* nA = has_next ? (const char*)g.A + (size_t)nxt.pm * tstep : cA; const char* nB = has_next ? (const char*)g.Bt + (size_t)nxt.pn * tstep : cB;
        for (int t = 0; t < nt; t += 2) {
            const bool last = (t == nt - 2);
            const char* a1 = cA + (size_t)(t + 1) * kstep;
            const char* a2 = last ? nA : cA + (size_t)(t + 2) * kstep; const char* b2 = last ? nB : cB + (size_t)(t + 2) * kstep;
            const char* a3 = a2 + kstep; const char* b3 = b2 + kstep;
            if (last && has_next) S.a_ready(nxt);
            if constexpr (SP2) {
            PG8_LDB(B0, 0, 0); PG8_LDB(B1, 0, 1); PG8_SCHED; PG8_LDA(At, 0, 0); PG8_STAGE(PG8_SA(1, 1), a1 + hstep, voffA);
            PG8_WAIT_V(8); PG8_WAIT_L(0); PG8_BAR; PG8_MMA(0, 0, At, B0); PG8_MMA(0, 1, At, B1); PG8_BAR; PG8_SCHED;
            PG8_LDA(At, 0, 1); PG8_STAGE(PG8_SB(0, 0), b2, voffB); PG8_STAGE(PG8_SB(0, 1), b2 + hstep, voffB); PG8_STAGE(PG8_SA(0, 0), a2, voffA);
            PG8_WAIT_V(8); PG8_WAIT_L(0); PG8_BAR; PG8_MMA(1, 0, At, B0); PG8_MMA(1, 1, At, B1); PG8_BAR; PG8_SCHED;
            PG8_LDB(B0, 1, 0); PG8_LDB(B1, 1, 1); PG8_SCHED; PG8_LDA(At, 1, 0); PG8_STAGE(PG8_SA(0, 1), a2 + hstep, voffA);
            PG8_WAIT_V(8); PG8_WAIT_L(0); PG8_BAR; PG8_MMA(0, 0, At, B0); PG8_MMA(0, 1, At, B1); PG8_BAR; PG8_SCHED;
            PG8_LDA(At, 1, 1); PG8_STAGE(PG8_SB(1, 0), b3, voffB); PG8_STAGE(PG8_SB(1, 1), b3 + hstep, voffB); PG8_STAGE(PG8_SA(1, 0), a3, voffA);
            PG8_WAIT_V(8); PG8_WAIT_L(0); PG8_BAR; PG8_MMA(1, 0, At, B0); PG8_MMA(1, 1, At, B1); PG8_BAR; PG8_SCHED;
            } else {
            PG8_LDB(B0, 0, 0); PG8_SCHED; PG8_LDA(At, 0, 0); PG8_STAGE(PG8_SA(1, 1), a1 + hstep, voffA);
            PG8_WAIT_L(8); PG8_BAR; PG8_WAIT_L(0); PG8_MMA(0, 0, At, B0); PG8_BAR; PG8_SCHED;
            PG8_LDB(B1, 0, 1); PG8_STAGE(PG8_SB(0, 0), b2, voffB);
            PG8_BAR; PG8_WAIT_L(0); PG8_MMA(0, 1, At, B1); PG8_BAR;
            PG8_LDA(At, 0, 1); PG8_STAGE(PG8_SA(0, 0), a2, voffA);
            PG8_BAR; PG8_WAIT_L(0); PG8_MMA(1, 0, At, B0); PG8_BAR; PG8_SCHED;
            PG8_STAGE(PG8_SB(0, 1), b2 + hstep, voffB);
            PG8_WAIT_V(6); PG8_BAR; PG8_MMA(1, 1, At, B1); PG8_BAR;
            PG8_LDB(B0, 1, 0); PG8_SCHED; PG8_LDA(At, 1, 0); PG8_STAGE(PG8_SA(0, 1), a2 + hstep, voffA);
            PG8_WAIT_L(8); PG8_BAR; PG8_WAIT_L(0); PG8_MMA(0, 0, At, B0); PG8_BAR; PG8_SCHED;
            PG8_LDB(B1, 1, 1); PG8_STAGE(PG8_SB(1, 0), b3, voffB);
            PG8_BAR; PG8_WAIT_L(0); PG8_MMA(0, 1, At, B1); PG8_BAR;
            PG8_LDA(At, 1, 1); PG8_STAGE(PG8_SA(1, 0), a3, voffA);
            PG8_BAR; PG8_WAIT_L(0); PG8_MMA(1, 0, At, B0); PG8_BAR; PG8_SCHED;
            PG8_STAGE(PG8_SB(1, 1), b3 + hstep, voffB);
            PG8_WAIT_V(6); PG8_BAR; PG8_MMA(1, 1, At, B1); PG8_BAR;
            }
        }
        if constexpr (ALIGN_EPI) { if (wr == 0) PG8_BAR; }
        if constexpr (!Epi::AFTER_DRAIN) { E(acc, cur, wr, wc, fr, fq); S.done(cur); }
        if (!has_next) break;
#pragma unroll
        for (int a = 0; a < 2; ++a)
#pragma unroll
            for (int b = 0; b < 2; ++b)
#pragma unroll
                for (int m = 0; m < 4; ++m)
#pragma unroll
                    for (int n = 0; n < 2; ++n) acc[a][b][m][n] = (f32x4){0.f, 0.f, 0.f, 0.f};
        cur = nxt; cA = nA; cB = nB; ++ui;
        if constexpr (ALIGN_EPI) { if (wr == 1) PG8_BAR; }
    }
    PG8_WAIT_V(0);
    if constexpr (!ALIGN_EPI) { if (wr == 0) PG8_BAR; }
    PG8_BAR;
    if constexpr (Epi::AFTER_DRAIN) { E.fused(acc, cur, wr, wc, fr, fq, lds, wid, lane); S.done(cur); }
#undef PG8_SA
#undef PG8_SB
#undef PG8_STAGE
#undef PG8_LDA
#undef PG8_LDB
#undef PG8_MMA
#undef PG8_WAIT_V
#undef PG8_WAIT_L
#undef PG8_BAR
#undef PG8_SCHED
}
}

#ifndef PROBE_MASK
#define PROBE_MASK 0
#endif
#ifndef PROBE_N
#define PROBE_N 1
#endif
constexpr int NWAVES = 8, NTHR = 512;
constexpr int TOK = 16384, SEQ = 4096, DM = 1024, FF = 2816, MODLD = 9216;
constexpr float EPS = 1e-6f;
constexpr size_t MiB = 1u << 20;
constexpr size_t WS_BAR = 0;
constexpr size_t WS_SSQ = 64 * 1024;
constexpr size_t CTL_ZERO_BYTES = 512 * 1024;
constexpr size_t WS_MOD = 1 * MiB;
constexpr size_t WS_BIAS = WS_MOD + 512 * 1024;
constexpr int BIAS_IN0 = 4 * 4 * 5632, BIAS_IN1 = BIAS_IN0 + 4 * 2560;
constexpr size_t WS_WGU = 2 * MiB;
constexpr size_t WS_WD = 46 * MiB;
constexpr size_t WS_WHYIN = 68 * MiB;
constexpr size_t WS_WHYOUT = 73 * MiB;
constexpr size_t WS_WSCIN = 75 * MiB;
constexpr size_t WS_WSCOUT = 81 * MiB;
constexpr size_t WS_H = 83 * MiB;
constexpr size_t WS_R1 = 115 * MiB;
constexpr size_t WS_VT = WS_R1 + 64 * MiB;
constexpr size_t WS_HB = 211 * MiB;
constexpr size_t WS_XB = 243 * MiB;
constexpr size_t WS_END = 275 * MiB;
constexpr int LDS_BYTES = 131072 + 1024;

#define GAS __attribute__((address_space(1)))
#define LAS __attribute__((address_space(3)))
typedef unsigned short bf16;
typedef unsigned v4u __attribute__((ext_vector_type(4)));
typedef unsigned v2u __attribute__((ext_vector_type(2)));
typedef float f32x4 __attribute__((ext_vector_type(4)));
typedef float f32x16 __attribute__((ext_vector_type(16)));
typedef short bf16x8 __attribute__((ext_vector_type(8)));
#define LDS_WAIT() asm volatile("s_waitcnt lgkmcnt(0)" ::: "memory")

__device__ __forceinline__ unsigned pk2(float lo, float hi) { return pg8::cvt_pk_bf16(lo, hi); }
__device__ __forceinline__ float bf2f(unsigned short v) { return __uint_as_float((unsigned)v << 16); }
__device__ __forceinline__ float bflo(unsigned w) { return __uint_as_float(w << 16); }
__device__ __forceinline__ float bfhi(unsigned w) { return __uint_as_float(w & 0xffff0000u); }
__device__ __forceinline__ float wave_sum(float v) {
#pragma unroll
    for (int o = 1; o < 64; o <<= 1) v += __shfl_xor(v, o);
    return v;
}

#define XB_TMO      128
#define XB_XCNT(j)  (256  + 64 * (j))
#define XB_XSUB(j)  (1280 + 64 * (j))
#define XB_XGEN(j)  (2304 + 64 * (j))
#define XB_TOP      3328
#define XB_TOPGEN   3392
#define XCD_BAR_WORDS 3456
#define XB_SPIN_CAP (1u << 18)

__device__ __forceinline__ unsigned xb_ld(unsigned* p)              { return __hip_atomic_load(p, __ATOMIC_RELAXED, __HIP_MEMORY_SCOPE_AGENT); }
__device__ __forceinline__ unsigned xb_add(unsigned* p, unsigned v) { return __hip_atomic_fetch_add(p, v, __ATOMIC_RELAXED, __HIP_MEMORY_SCOPE_AGENT); }
__device__ __forceinline__ unsigned xb_xcc_id() { return (unsigned)__builtin_amdgcn_s_getreg((3 << 11) | 20) & 0xFu; }
#define XB_SPIN(cond, bar) do { unsigned _sp = 0; while (cond) { __builtin_amdgcn_s_sleep(1); \
    if ((++_sp & 255u) == 0u) { if (xb_ld(&(bar)[XB_TMO])) break; if (_sp > XB_SPIN_CAP) { atomicAdd(&(bar)[XB_TMO], 1u); break; } } } } while (0)

struct XcdBarrier {
    unsigned* bar; unsigned x;
    volatile LAS unsigned* st;
};

__device__ __forceinline__ XcdBarrier xcd_barrier_post(unsigned* bar, volatile LAS unsigned* st) {
    XcdBarrier b; b.bar = bar; b.x = xb_xcc_id(); b.st = st;
    if (threadIdx.x == 0) (void)xb_add(&bar[XB_XCNT(b.x)], 1u);
    return b;
}
__device__ __forceinline__ void xcd_barrier_complete(unsigned* bar, unsigned x, unsigned& nloc, unsigned& nx) {
    const unsigned G = gridDim.x * gridDim.y * gridDim.z;
    unsigned sum, cnt, mine, sp = 0u;
    for (;;) {
        sum = 0u; cnt = 0u; mine = 0u;
#pragma unroll
        for (unsigned j = 0; j < 16; ++j) { const unsigned c = xb_ld(&bar[XB_XCNT(j)]); sum += c; cnt += (c > 0u) ? 1u : 0u; mine = (j == x) ? c : mine; }
        if (sum == G) break;
        __builtin_amdgcn_s_sleep(1);
        if ((++sp & 255u) == 0u) { if (xb_ld(&bar[XB_TMO])) break; if (sp > XB_SPIN_CAP) { atomicAdd(&bar[XB_TMO], 1u); break; } }
    }
    nloc = mine > 0u ? mine : 1u; nx = cnt > 0u ? cnt : 1u;
}

__device__ __forceinline__ void xcd_barrier(const XcdBarrier& b) {
    asm volatile("s_waitcnt vmcnt(0)" ::: "memory");
    __syncthreads();
    if (threadIdx.x == 0) {
        unsigned* bar = b.bar;
        __builtin_amdgcn_s_waitcnt(0);
        unsigned nloc = b.st[0], nx = b.st[1];
        if (nloc == 0u) { xcd_barrier_complete(bar, b.x, nloc, nx); b.st[0] = nloc; b.st[1] = nx; }
        const unsigned old = xb_add(&bar[XB_XSUB(b.x)], 1u);
        const unsigned gen = old / nloc;
        if (old + 1u == (gen + 1u) * nloc) {
            __builtin_amdgcn_fence(__ATOMIC_RELEASE, "agent");
            asm volatile("s_waitcnt vmcnt(0)" ::: "memory");
            const unsigned og = xb_add(&bar[XB_TOP], 1u);
            const unsigned tg = og / nx;
            if (og + 1u == (tg + 1u) * nx) xb_add(&bar[XB_TOPGEN], 1u);
            else XB_SPIN(xb_ld(&bar[XB_TOPGEN]) == tg, bar);
            __builtin_amdgcn_fence(__ATOMIC_ACQUIRE, "agent");
            xb_add(&bar[XB_XGEN(b.x)], 1u);
            asm volatile("s_waitcnt vmcnt(0)" ::: "memory");
        } else {
            XB_SPIN(xb_ld(&bar[XB_XGEN(b.x)]) == gen, bar);
            __builtin_amdgcn_fence(__ATOMIC_ACQUIRE, "agent");
            asm volatile("s_waitcnt vmcnt(0)" ::: "memory");
        }
    }
    __syncthreads();
}

struct Args { const float* in[17]; float* out; unsigned char* ws; int lo, hi; };

struct TrItem { const float* src; bf16* dst; int N, K; };
__device__ __forceinline__ TrItem tr_make(const float* W, int K, int N, bf16* WT, int kind, int item) {
    const int nblk = N / 32, kb = item / nblk, nb = item % nblk, k0 = 64 * kb, n0 = 32 * nb;
    int orow0 = n0; if (kind == 1) orow0 = 256 * (n0 >> 7) + (n0 & 127); else if (kind == 2) orow0 = 256 * (n0 >> 7) + 128 + (n0 & 127);
    TrItem t; t.src = W + (size_t)k0 * N + n0; t.dst = WT + (size_t)orow0 * K + k0; t.N = N; t.K = K; return t;
}
__device__ __forceinline__ int mat_items(int id) { return id < 0 ? 0 : (id < 4 ? 2816 : (id < 8 ? 1408 : (id == 8 ? 1280 : (id == 10 ? 1536 : 512)))); }
__device__ __forceinline__ TrItem tr_decode_mat(const Args& A, unsigned char* ws, int id, int r) {
    if (id < 4) { if (r < 1408) return tr_make(A.in[5] + (size_t)id * DM * FF, DM, FF, (bf16*)(ws + WS_WGU) + (size_t)id * 5632 * 1024, 1, r);
                  return tr_make(A.in[6] + (size_t)id * DM * FF, DM, FF, (bf16*)(ws + WS_WGU) + (size_t)id * 5632 * 1024, 2, r - 1408); }
    if (id < 8) return tr_make(A.in[7] + (size_t)(id - 4) * FF * DM, FF, DM, (bf16*)(ws + WS_WD) + (size_t)(id - 4) * 1024 * FF, 0, r);
    if (id == 8) return tr_make(A.in[8], DM, 2560, (bf16*)(ws + WS_WHYIN), 0, r);
    if (id == 9) return tr_make(A.in[9], DM, DM, (bf16*)(ws + WS_WHYOUT), 0, r);
    if (id == 10) return tr_make(A.in[13], DM, 3072, (bf16*)(ws + WS_WSCIN), 0, r);
    return tr_make(A.in[15], DM, DM, (bf16*)(ws + WS_WSCOUT), 0, r);
}
__device__ __forceinline__ void slot_mats(int sel, int& m0, int& m1, int& m2) {
    m0 = (sel == 0) ? 0 : (sel == 1) ? 4 : (sel == 2) ? 5 : (sel == 3) ? 3 : 6;
    m1 = (sel == 0) ? 8 : (sel == 1) ? 1 : (sel == 2) ? 2 : (sel == 3) ? 10 : 7;
    m2 = (sel == 1) ? 9 : (sel == 4) ? 11 : -1;
}
__device__ __forceinline__ TrItem tr_decode(const Args& A, unsigned char* ws, int sel, int it) {
    int m0, m1, m2; slot_mats(sel, m0, m1, m2);
    const int n0 = mat_items(m0), n1 = mat_items(m1);
    if (it < n0) return tr_decode_mat(A, ws, m0, it);
    if (it < n0 + n1) return tr_decode_mat(A, ws, m1, it - n0);
    return tr_decode_mat(A, ws, m2, it - n0 - n1);
}
__device__ __forceinline__ void convert_items(const Args& A, unsigned char* ws, LAS float* scr, int sel, int gw, int NGW, int lane) {
    int sm0, sm1, sm2; slot_mats(sel, sm0, sm1, sm2);
    const int nitems = mat_items(sm0) + mat_items(sm1) + mat_items(sm2);
    int it = gw;
    if (it >= nitems) return;
    const int l5 = lane >> 5, l31 = lane & 31, c = lane & 7, nj = lane >> 3;
    TrItem cur = tr_decode(A, ws, sel, it);
    float tv[32];
#pragma unroll
    for (int i = 0; i < 32; ++i) tv[i] = cur.src[(size_t)(2 * i + l5) * cur.N + l31];
    for (;;) {
#pragma unroll
        for (int i = 0; i < 32; ++i) scr[(2 * i + l5) * 33 + l31] = tv[i];
        const int itn = it + NGW; const bool more = itn < nitems;
        const TrItem nxt = tr_decode(A, ws, sel, more ? itn : it);
#pragma unroll
        for (int i = 0; i < 32; ++i) tv[i] = nxt.src[(size_t)(2 * i + l5) * nxt.N + l31];
        LDS_WAIT(); asm volatile("" ::: "memory");
#pragma unroll
        for (int j = 0; j < 4; ++j) { const int n = nj + 8 * j; const LAS float* sp = scr + (8 * c) * 33 + n;
            v4u o; o.x = pk2(sp[0 * 33], sp[1 * 33]); o.y = pk2(sp[2 * 33], sp[3 * 33]); o.z = pk2(sp[4 * 33], sp[5 * 33]); o.w = pk2(sp[6 * 33], sp[7 * 33]);
            *(v4u*)(cur.dst + (size_t)n * cur.K + 8 * c) = o; }
        LDS_WAIT(); asm volatile("" ::: "memory");
        if (!more) break;
        cur = nxt; it = itn;
    }
}
__device__ __forceinline__ void phase_prologue(const Args& A, LAS unsigned char* lds, int G) {
    int tid_ = threadIdx.x; asm volatile("" : "+v"(tid_)); const int tid = tid_, lane = tid & 63, wid = tid >> 6;
    unsigned char* ws = A.ws;
    {
        LAS float* cs = (LAS float*)lds;
        LAS float* part = (LAS float*)(lds + 16384);
        const float* cin = A.in[1];
        for (int i = tid; i < 4096; i += NTHR) { const float c = cin[i]; cs[i] = c / (1.0f + __expf(-c)); }
        __syncthreads();
        const float* mod_w = A.in[2]; const float* mod_b = A.in[3]; float* MOD = (float*)(ws + WS_MOD);
        const int col = lane & 31, kg = wid * 2 + (lane >> 5);
        for (int unit = blockIdx.x; unit < 576; unit += G) {
            const int L = unit / 288, n0 = (unit % 288) * 32;
            const float* W = mod_w + (size_t)L * 1024 * MODLD + (size_t)(64 * kg) * MODLD + n0 + col;
            float a0 = 0.f, a1 = 0.f, a2 = 0.f, a3 = 0.f;
#pragma unroll 16
            for (int k = 0; k < 64; ++k) { const float w = W[(size_t)k * MODLD]; const int kk = 64 * kg + k;
                a0 += cs[kk] * w; a1 += cs[1024 + kk] * w; a2 += cs[2048 + kk] * w; a3 += cs[3072 + kk] * w; }
            part[(kg * 4 + 0) * 32 + col] = a0; part[(kg * 4 + 1) * 32 + col] = a1; part[(kg * 4 + 2) * 32 + col] = a2; part[(kg * 4 + 3) * 32 + col] = a3;
            __syncthreads();
            if (tid < 128) { const int b = tid >> 5, c = tid & 31; float s = mod_b[L * MODLD + n0 + c];
#pragma unroll
                for (int g = 0; g < 16; ++g) s += part[(g * 4 + b) * 32 + c];
                const int seg = (n0 + c) >> 10; if (seg == 2 || seg == 8) s *= 0.5f;
                MOD[(size_t)(L * 4 + b) * MODLD + n0 + c] = s; }
            __syncthreads();
        }
    }
    convert_items(A, ws, (LAS float*)(lds + wid * 16384), 0, blockIdx.x * NWAVES + wid, G * NWAVES, lane);
}

__device__ __forceinline__ void phase_norm0(const float* x, const float* g, const float* scale, bf16* XS, bf16* XB, float* ssq, int G) {
    int tid_ = threadIdx.x; asm volatile("" : "+v"(tid_)); const int tid = tid_, lane = tid & 63, wid = tid >> 6;
    const int gw = blockIdx.x * NWAVES + wid, NGW = G * NWAVES;
    f32x4 gv[4];
#pragma unroll
    for (int j = 0; j < 4; ++j) gv[j] = ((const f32x4*)g)[64 * j + lane];
    const bool aff = (G == 256);
    const int mstep = aff ? 256 : NGW; int m = aff ? 2048 * ((int)blockIdx.x & 7) + ((int)blockIdx.x >> 3) * NWAVES + wid : gw;
    int left = aff ? 8 : (gw < TOK ? (TOK - gw + NGW - 1) / NGW : 0);
    if (left == 0) return;
    f32x4 v[4];
#pragma unroll
    for (int j = 0; j < 4; ++j) v[j] = ((const f32x4*)(x + (size_t)m * DM))[64 * j + lane];
    for (;;) {
        const int mn = m + mstep; const bool more = left > 1; const int ml = more ? mn : m; --left;
        f32x4 nv[4];
#pragma unroll
        for (int j = 0; j < 4; ++j) nv[j] = ((const f32x4*)(x + (size_t)ml * DM))[64 * j + lane];
        const int b = m >> 12; float s = 0.f;
#pragma unroll
        for (int j = 0; j < 4; ++j) s += (v[j].x * v[j].x + v[j].y * v[j].y) + (v[j].z * v[j].z + v[j].w * v[j].w);
        s = wave_sum(s);
        if (lane == 0) ssq[m] = s;
        unsigned long long* o8 = (unsigned long long*)(XS + (size_t)m * DM) + lane; unsigned long long* x8 = (unsigned long long*)(XB + (size_t)m * DM) + lane;
#pragma unroll
        for (int j = 0; j < 4; ++j) {
            const f32x4 sc = ((const f32x4*)(scale + (size_t)b * MODLD))[64 * j + lane];
            const f32x4 y = v[j] * gv[j] * (sc + 1.0f);
            o8[64 * j] = (unsigned long long)pk2(y.x, y.y) | ((unsigned long long)pk2(y.z, y.w) << 32);
            x8[64 * j] = (unsigned long long)pk2(v[j].x, v[j].y) | ((unsigned long long)pk2(v[j].z, v[j].w) << 32);
        }
        if (!more) break;
#pragma unroll
        for (int j = 0; j < 4; ++j) v[j] = nv[j];
        m = mn;
    }
}
__device__ __forceinline__ void bias_rows(const bf16* Wt, int nrows, const float* shift, float* out, int pitch, int gw, int NGW, int lane) {
    f32x4 sh[4][4];
#pragma unroll
    for (int b = 0; b < 4; ++b)
#pragma unroll
        for (int q = 0; q < 4; ++q) sh[b][q] = *(const f32x4*)(shift + (size_t)b * MODLD + 16 * lane + 4 * q);
    for (int n = gw; n < nrows; n += 2 * NGW) {
        const int n2 = n + NGW; const bool has2 = n2 < nrows; const int n2c = has2 ? n2 : n;
        const v4u w0 = *(const v4u*)(Wt + (size_t)n * DM + 16 * lane), w1 = *(const v4u*)(Wt + (size_t)n * DM + 16 * lane + 8);
        const v4u x0 = *(const v4u*)(Wt + (size_t)n2c * DM + 16 * lane), x1 = *(const v4u*)(Wt + (size_t)n2c * DM + 16 * lane + 8);
        const f32x4 f0 = {bflo(w0.x), bfhi(w0.x), bflo(w0.y), bfhi(w0.y)}, f1 = {bflo(w0.z), bfhi(w0.z), bflo(w0.w), bfhi(w0.w)};
        const f32x4 f2 = {bflo(w1.x), bfhi(w1.x), bflo(w1.y), bfhi(w1.y)}, f3 = {bflo(w1.z), bfhi(w1.z), bflo(w1.w), bfhi(w1.w)};
        const f32x4 g0 = {bflo(x0.x), bfhi(x0.x), bflo(x0.y), bfhi(x0.y)}, g1 = {bflo(x0.z), bfhi(x0.z), bflo(x0.w), bfhi(x0.w)};
        const f32x4 g2 = {bflo(x1.x), bfhi(x1.x), bflo(x1.y), bfhi(x1.y)}, g3 = {bflo(x1.z), bfhi(x1.z), bflo(x1.w), bfhi(x1.w)};
        float acc[4], acd[4];
#pragma unroll
        for (int b = 0; b < 4; ++b) { const f32x4 t = sh[b][0] * f0 + sh[b][1] * f1 + sh[b][2] * f2 + sh[b][3] * f3; acc[b] = wave_sum((t.x + t.y) + (t.z + t.w));
            const f32x4 u = sh[b][0] * g0 + sh[b][1] * g1 + sh[b][2] * g2 + sh[b][3] * g3; acd[b] = wave_sum((u.x + u.y) + (u.z + u.w)); }
        if (lane == 0) { out[n] = acc[0]; out[pitch + n] = acc[1]; out[2 * pitch + n] = acc[2]; out[3 * pitch + n] = acc[3];
            if (has2) { out[n2] = acd[0]; out[pitch + n2] = acd[1]; out[2 * pitch + n2] = acd[2]; out[3 * pitch + n2] = acd[3]; } }
    }
}
__device__ __forceinline__ void bias_sets(unsigned char* ws, int sel, int gw, int NGW, int lane) {
    const float* MOD = (const float*)(ws + WS_MOD); float* BIAS = (float*)(ws + WS_BIAS);
    const int f = sel;
    bias_rows((const bf16*)(ws + WS_WGU) + (size_t)f * 5632 * 1024, 5632, MOD + (size_t)(f >> 1) * 4 * MODLD + ((f & 1) ? 6 * DM : 0), BIAS + (size_t)f * 4 * 5632, 5632, gw, NGW, lane);
    if (sel == 0) bias_rows((const bf16*)(ws + WS_WHYIN), 2560, MOD + 3 * DM, BIAS + BIAS_IN0, 2560, gw, NGW, lane);
    if (sel == 3) bias_rows((const bf16*)(ws + WS_WSCIN), 3072, MOD + (size_t)4 * MODLD + 3 * DM, BIAS + BIAS_IN1, 3072, gw, NGW, lane);
}
__device__ __forceinline__ void filler(const Args& A, unsigned char* ws, LAS unsigned char* lds, int p, int G) {
    const bool half = (G == 256);
    if (half && (int)blockIdx.x < 128) return;
    int tid_ = threadIdx.x; asm volatile("" : "+v"(tid_)); const int tid = tid_, lane = tid & 63, wid = tid >> 6;
    const int gw = ((int)blockIdx.x - (half ? 128 : 0)) * NWAVES + wid, NGW = (half ? 128 : G) * NWAVES;
    LAS float* scr = (LAS float*)(lds + wid * 16384);
    if (p == 2) convert_items(A, ws, scr, 1, gw, NGW, lane);
    else if (p == 4) { convert_items(A, ws, scr, 2, gw, NGW, lane); bias_sets(ws, 1, gw, NGW, lane); }
    else if (p == 7) { convert_items(A, ws, scr, 3, gw, NGW, lane); bias_sets(ws, 2, gw, NGW, lane); }
    else if (p == 9) { convert_items(A, ws, scr, 4, gw, NGW, lane); bias_sets(ws, 3, gw, NGW, lane); }
}
__device__ __forceinline__ void phase_bias(unsigned char* ws, int G) {
    int tid_ = threadIdx.x; asm volatile("" : "+v"(tid_)); const int tid = tid_, lane = tid & 63, wid = tid >> 6;
    bias_sets(ws, 0, blockIdx.x * NWAVES + wid, G * NWAVES, lane);
}
__device__ __forceinline__ void phase_final_norm(const bf16* xb, float* out, const float* g, const float* ssq, int G) {
    int tid_ = threadIdx.x; asm volatile("" : "+v"(tid_)); const int tid = tid_, lane = tid & 63, wid = tid >> 6;
    const int gw = blockIdx.x * NWAVES + wid, NGW = G * NWAVES;
    f32x4 gv[4];
#pragma unroll
    for (int j = 0; j < 4; ++j) gv[j] = ((const f32x4*)g)[64 * j + lane];
    const bool aff = (G == 256);
    const int mstep = aff ? 256 : NGW; int m = aff ? 2048 * ((int)blockIdx.x & 7) + ((int)blockIdx.x >> 3) * NWAVES + wid : gw;
    int left = aff ? 8 : (gw < TOK ? (TOK - gw + NGW - 1) / NGW : 0);
    if (left == 0) return;
    v2u v[4]; float sq = ssq[m];
#pragma unroll
    for (int j = 0; j < 4; ++j) v[j] = ((const v2u*)(xb + (size_t)m * DM))[64 * j + lane];
    for (;;) {
        const int mn = m + mstep; const bool more = left > 1; const int ml = more ? mn : m; --left;
        v2u nv[4]; const float nsq = ssq[ml];
#pragma unroll
        for (int j = 0; j < 4; ++j) nv[j] = ((const v2u*)(xb + (size_t)ml * DM))[64 * j + lane];
        const float rstd = __builtin_amdgcn_rsqf(sq * (1.0f / DM) + EPS);
        f32x4* xr = (f32x4*)(out + (size_t)m * DM) + lane;
#pragma unroll
        for (int j = 0; j < 4; ++j) { const f32x4 xv = {bflo(v[j].x), bfhi(v[j].x), bflo(v[j].y), bfhi(v[j].y)}; xr[64 * j] = xv * rstd * gv[j]; }
        if (!more) break;
#pragma unroll
        for (int j = 0; j < 4; ++j) v[j] = nv[j];
        sq = nsq; m = mn;
    }
}

__device__ __forceinline__ int sgu_unit_id(bool aff, int bx, int G, int it) {
    const int xx = bx & 7, jj = bx >> 3;
    return aff ? (((xx >> 1) << 8) | ((((xx & 1) * 16 + 4 * (jj >> 3) + it)) << 3) | (jj & 7)) : bx + it * G;
}
__device__ __forceinline__ void sgu_phase(const bf16* P1, bf16* Y, const float* vng, const float* w_s, const float* b_s, LAS unsigned char* lds, int G) {
    int tid_ = threadIdx.x; asm volatile("" : "+v"(tid_)); const int tid = tid_, lane = tid & 63, wid = __builtin_amdgcn_readfirstlane(tid >> 6);
    constexpr int VS = 272, VBUF = 64 * VS, WSL = 2 * VBUF;
    const int sl = tid >> 2, dq = tid & 3;
    const int tb = wid >> 1, db = wid & 1, r = lane & 31, hh = lane >> 5, t = 32 * tb + r, d = 32 * db + r, nkc = 2 * (tb + 1);
    const bool aff = (G == 256); const int bx = blockIdx.x; const int nit = aff ? 4 : (bx < 1024 ? (1024 - bx + G - 1) / G : 0);
    if (nit == 0) return;
    int unit = sgu_unit_id(aff, bx, G, 0);
    v4u r0, r1; v2u uq[4]; float bt;
    { const int hA = unit & 7, chunk = (unit >> 3) & 31, b = unit >> 8; const size_t row0 = (size_t)b * SEQ + chunk * 128;
      const bf16* vp = P1 + (row0 + sl) * 2048 + 512 + hA * 64 + dq * 16; r0 = *(const v4u*)vp; r1 = *(const v4u*)(vp + 8);
#pragma unroll
      for (int g = 0; g < 4; ++g) uq[g] = *(const v2u*)(P1 + (row0 + t) * 2048 + hA * 64 + 32 * db + 8 * g + 4 * hh);
      bt = b_s[hA * 128 + t]; }
    int cur = 0, curh = -1;
    for (int it = 0; it < nit; ++it) {
        unit = sgu_unit_id(aff, bx, G, it);
        const int hA = unit & 7, chunk = (unit >> 3) & 31, b = unit >> 8;
        const size_t row0 = (size_t)b * SEQ + chunk * 128;
        LAS unsigned char* vbuf = lds + cur * VBUF;
        if (hA != curh) {
            if (curh >= 0) __syncthreads();
            const int wr_ = tid >> 2, wq_ = tid & 3; const float* wp = w_s + ((size_t)hA * 128 + wr_) * 128 + 32 * wq_;
            f32x4 wl[8];
#pragma unroll
            for (int q = 0; q < 8; ++q) wl[q] = *(const f32x4*)(wp + 4 * q);
#pragma unroll
            for (int q = 0; q < 4; ++q) { const int s0_ = 32 * wq_ + 8 * q; float wf[8] = {wl[2 * q].x, wl[2 * q].y, wl[2 * q].z, wl[2 * q].w, wl[2 * q + 1].x, wl[2 * q + 1].y, wl[2 * q + 1].z, wl[2 * q + 1].w};
#pragma unroll
                for (int j = 0; j < 8; ++j) wf[j] = (s0_ + j <= wr_) ? wf[j] : 0.f;
                v4u au; au.x = pk2(wf[0], wf[1]); au.y = pk2(wf[2], wf[3]); au.z = pk2(wf[4], wf[5]); au.w = pk2(wf[6], wf[7]);
                *(LAS v4u*)(lds + WSL + wr_ * VS + (s0_ * 2)) = au; }
            curh = hA;
        }
        {
            float f[16];
            f[0] = bflo(r0.x); f[1] = bfhi(r0.x); f[2] = bflo(r0.y); f[3] = bfhi(r0.y); f[4] = bflo(r0.z); f[5] = bfhi(r0.z); f[6] = bflo(r0.w); f[7] = bfhi(r0.w);
            f[8] = bflo(r1.x); f[9] = bfhi(r1.x); f[10] = bflo(r1.y); f[11] = bfhi(r1.y); f[12] = bflo(r1.z); f[13] = bfhi(r1.z); f[14] = bflo(r1.w); f[15] = bfhi(r1.w);
            float ss = 0.f;
#pragma unroll
            for (int i = 0; i < 16; ++i) ss += f[i] * f[i];
            ss += __shfl_xor(ss, 1); ss += __shfl_xor(ss, 2);
            const float rstd = __builtin_amdgcn_rsqf(ss * (1.0f / 64.0f) + EPS);
#pragma unroll
            for (int i = 0; i < 16; ++i) { const int dd = dq * 16 + i; const float y = f[i] * rstd * vng[hA * 64 + dd];
                *(LAS unsigned short*)(vbuf + dd * VS + sl * 2) = (unsigned short)(pk2(y, 0.f) & 0xffffu); }
        }
        const int un = sgu_unit_id(aff, bx, G, (it + 1 < nit) ? it + 1 : it);
        const int hA2 = un & 7, chunk2 = (un >> 3) & 31, b2 = un >> 8; const size_t row2 = (size_t)b2 * SEQ + chunk2 * 128;
        { const bf16* vp = P1 + (row2 + sl) * 2048 + 512 + hA2 * 64 + dq * 16; r0 = *(const v4u*)vp; r1 = *(const v4u*)(vp + 8); }
        __syncthreads();
        f32x16 acc;
#pragma unroll
        for (int i = 0; i < 16; ++i) acc[i] = 0.f;
        const LAS unsigned char* vb = vbuf + d * VS + 16 * hh; const LAS unsigned char* wt = lds + WSL + t * VS + 16 * hh;
#pragma unroll
        for (int kc = 0; kc < 8; ++kc) if (kc < nkc) {
            const bf16x8 wf = *(const LAS bf16x8*)(wt + 32 * kc);
            const bf16x8 vf = *(const LAS bf16x8*)(vb + 32 * kc);
            acc = __builtin_amdgcn_mfma_f32_32x32x16_bf16(vf, wf, acc, 0, 0, 0);
        }
        v2u o[4];
#pragma unroll
        for (int g = 0; g < 4; ++g) { const float y0 = bflo(uq[g].x) * (acc[4 * g] + bt), y1 = bfhi(uq[g].x) * (acc[4 * g + 1] + bt), y2 = bflo(uq[g].y) * (acc[4 * g + 2] + bt), y3 = bfhi(uq[g].y) * (acc[4 * g + 3] + bt);
            o[g].x = pk2(y0, y1); o[g].y = pk2(y2, y3); }
#pragma unroll
        for (int g = 0; g < 4; ++g) uq[g] = *(const v2u*)(P1 + (row2 + t) * 2048 + hA2 * 64 + 32 * db + 8 * g + 4 * hh);
        bt = b_s[hA2 * 128 + t];
#pragma unroll
        for (int g = 0; g < 4; ++g) *(v2u*)(Y + (row0 + t) * 1024 + hA * 64 + 32 * db + 8 * g + 4 * hh) = o[g];
        cur ^= 1;
    }
}

typedef float f32x2 __attribute__((ext_vector_type(2)));
struct SbK { float c0, c1, cm; };
template <int ODD> __device__ __forceinline__ float mul_np(float a, float b, const SbK& k) { return ODD ? __builtin_fmaf(a, b, k.c0) : a * b; }
template <int ODD> __device__ __forceinline__ float inc_np(float e, const SbK& k) { return ODD ? __builtin_fmaf(e, k.c1, 1.0f) : 1.0f + e; }
template <int ODD> __device__ __forceinline__ float omb_np(float be, const SbK& k) { return ODD ? __builtin_fmaf(be, k.cm, 1.0f) : 1.0f - be; }
template <bool MASK> __device__ __forceinline__ void sb_block(const f32x16& sc, int kb0, int t, int hh, float& R, bf16x8& pb0, bf16x8& pb1, const SbK& k) {
    float be[16], om[16];
#pragma unroll
    for (int i = 0; i < 16; i += 2) {
        const float e0 = __builtin_amdgcn_exp2f(sc[i]), e1 = __builtin_amdgcn_exp2f(sc[i + 1]);
        be[i] = __builtin_amdgcn_rcpf(inc_np<0>(e0, k)); be[i + 1] = __builtin_amdgcn_rcpf(inc_np<1>(e1, k));
        om[i] = omb_np<0>(be[i], k); om[i + 1] = omb_np<1>(be[i + 1], k);
    }
    if (MASK) {
#pragma unroll
        for (int i = 0; i < 16; ++i) { const int key = kb0 + 16 * (i >> 3) + 8 * hh + (i & 7); const bool ok = key < t; be[i] = ok ? be[i] : 0.f; om[i] = ok ? om[i] : 1.0f; }
    }
    float ex[16];
    ex[7] = 1.0f; ex[15] = 1.0f;
    ex[6] = om[7]; ex[14] = om[15];
#pragma unroll
    for (int j = 5; j >= 0; --j) { ex[j] = mul_np<0>(ex[j + 1], om[j + 1], k); ex[8 + j] = mul_np<1>(ex[8 + j + 1], om[8 + j + 1], k); }
    const float T0 = mul_np<0>(ex[0], om[0], k), T1 = mul_np<1>(ex[8], om[8], k);
    const float Tp0 = __shfl_xor(T0, 32), Tp1 = __shfl_xor(T1, 32);
    const float P1t = T1 * Tp1, PR = P1t * R;
    const float A0 = (hh == 0 ? Tp0 : 1.0f) * PR, A1 = __builtin_fmaf(hh == 0 ? Tp1 : 1.0f, R, k.c0);
    R = (T0 * Tp0) * PR;
    float w[16];
    w[7] = mul_np<1>(be[7], A0, k); w[15] = mul_np<0>(be[15], A1, k);
#pragma unroll
    for (int j = 0; j < 7; ++j) {
        if (j & 1) { w[j] = mul_np<1>(mul_np<1>(be[j], ex[j], k), A0, k); w[8 + j] = mul_np<0>(mul_np<0>(be[8 + j], ex[8 + j], k), A1, k); }
        else       { w[j] = mul_np<0>(mul_np<0>(be[j], ex[j], k), A0, k); w[8 + j] = mul_np<1>(mul_np<1>(be[8 + j], ex[8 + j], k), A1, k); }
    }
    v4u pu0, pu1;
    pu0.x = pk2(w[0], w[1]); pu0.y = pk2(w[2], w[3]); pu0.z = pk2(w[4], w[5]); pu0.w = pk2(w[6], w[7]);
    pu1.x = pk2(w[8], w[9]); pu1.y = pk2(w[10], w[11]); pu1.z = pk2(w[12], w[13]); pu1.w = pk2(w[14], w[15]);
    pb0 = __builtin_bit_cast(bf16x8, pu0); pb1 = __builtin_bit_cast(bf16x8, pu1);
}
__device__ __forceinline__ void attn_tile(const LAS unsigned char* kbuf, const LAS unsigned char* vbuf, const bf16x8 (&bq)[4], int k0, int q0, int t, int n, int hh, int pin, f32x16& o0, f32x16& o1, float& R, const SbK& sk) {
    constexpr int RS = 144;
    if (k0 < q0 + 31) {
        const bool do1 = (k0 + 32 < q0 + 31);
        const LAS unsigned char* kp = kbuf + pin * RS + hh * 16;
        const LAS unsigned char* vp = vbuf + n * RS + hh * 16;
        const f32x16 z16 = {0.f, 0.f, 0.f, 0.f, 0.f, 0.f, 0.f, 0.f, 0.f, 0.f, 0.f, 0.f, 0.f, 0.f, 0.f, 0.f};
        bf16x8 pb0, pb1;
        if (k0 + 63 < q0) {
            f32x16 s0, s1;
            { const bf16x8 a1 = *(const LAS bf16x8*)(kp + 32 * RS), a0 = *(const LAS bf16x8*)(kp);
              s1 = __builtin_amdgcn_mfma_f32_32x32x16_bf16(a1, bq[0], z16, 0, 0, 0); s0 = __builtin_amdgcn_mfma_f32_32x32x16_bf16(a0, bq[0], z16, 0, 0, 0); }
#pragma unroll
            for (int c = 1; c < 4; ++c) { const bf16x8 a1 = *(const LAS bf16x8*)(kp + 32 * RS + c * 32), a0 = *(const LAS bf16x8*)(kp + c * 32);
                s1 = __builtin_amdgcn_mfma_f32_32x32x16_bf16(a1, bq[c], s1, 0, 0, 0); s0 = __builtin_amdgcn_mfma_f32_32x32x16_bf16(a0, bq[c], s0, 0, 0, 0); }
            sb_block<false>(s1, k0 + 32, t, hh, R, pb0, pb1, sk);
            { const bf16x8 a00 = *(const LAS bf16x8*)(vp + 64), a01 = *(const LAS bf16x8*)(vp + 32 * RS + 64), a10 = *(const LAS bf16x8*)(vp + 96), a11 = *(const LAS bf16x8*)(vp + 32 * RS + 96);
              o0 = __builtin_amdgcn_mfma_f32_32x32x16_bf16(a00, pb0, o0, 0, 0, 0); o1 = __builtin_amdgcn_mfma_f32_32x32x16_bf16(a01, pb0, o1, 0, 0, 0);
              o0 = __builtin_amdgcn_mfma_f32_32x32x16_bf16(a10, pb1, o0, 0, 0, 0); o1 = __builtin_amdgcn_mfma_f32_32x32x16_bf16(a11, pb1, o1, 0, 0, 0); }
            sb_block<false>(s0, k0, t, hh, R, pb0, pb1, sk);
            { const bf16x8 a00 = *(const LAS bf16x8*)(vp), a01 = *(const LAS bf16x8*)(vp + 32 * RS), a10 = *(const LAS bf16x8*)(vp + 32), a11 = *(const LAS bf16x8*)(vp + 32 * RS + 32);
              o0 = __builtin_amdgcn_mfma_f32_32x32x16_bf16(a00, pb0, o0, 0, 0, 0); o1 = __builtin_amdgcn_mfma_f32_32x32x16_bf16(a01, pb0, o1, 0, 0, 0);
              o0 = __builtin_amdgcn_mfma_f32_32x32x16_bf16(a10, pb1, o0, 0, 0, 0); o1 = __builtin_amdgcn_mfma_f32_32x32x16_bf16(a11, pb1, o1, 0, 0, 0); }
        } else {
            asm volatile("" ::: "memory");
            if (do1) {
                f32x16 s1 = __builtin_amdgcn_mfma_f32_32x32x16_bf16(*(const LAS bf16x8*)(kp + 32 * RS), bq[0], z16, 0, 0, 0);
#pragma unroll
                for (int c = 1; c < 4; ++c) s1 = __builtin_amdgcn_mfma_f32_32x32x16_bf16(*(const LAS bf16x8*)(kp + 32 * RS + c * 32), bq[c], s1, 0, 0, 0);
                sb_block<true>(s1, k0 + 32, t, hh, R, pb0, pb1, sk);
                const bf16x8 a00 = *(const LAS bf16x8*)(vp + 64), a01 = *(const LAS bf16x8*)(vp + 32 * RS + 64), a10 = *(const LAS bf16x8*)(vp + 96), a11 = *(const LAS bf16x8*)(vp + 32 * RS + 96);
                o0 = __builtin_amdgcn_mfma_f32_32x32x16_bf16(a00, pb0, o0, 0, 0, 0); o1 = __builtin_amdgcn_mfma_f32_32x32x16_bf16(a01, pb0, o1, 0, 0, 0);
                o0 = __builtin_amdgcn_mfma_f32_32x32x16_bf16(a10, pb1, o0, 0, 0, 0); o1 = __builtin_amdgcn_mfma_f32_32x32x16_bf16(a11, pb1, o1, 0, 0, 0);
            }
            {
                f32x16 s0 = __builtin_amdgcn_mfma_f32_32x32x16_bf16(*(const LAS bf16x8*)(kp), bq[0], z16, 0, 0, 0);
#pragma unroll
                for (int c = 1; c < 4; ++c) s0 = __builtin_amdgcn_mfma_f32_32x32x16_bf16(*(const LAS bf16x8*)(kp + c * 32), bq[c], s0, 0, 0, 0);
                sb_block<true>(s0, k0, t, hh, R, pb0, pb1, sk);
                const bf16x8 a00 = *(const LAS bf16x8*)(vp), a01 = *(const LAS bf16x8*)(vp + 32 * RS), a10 = *(const LAS bf16x8*)(vp + 32), a11 = *(const LAS bf16x8*)(vp + 32 * RS + 32);
                o0 = __builtin_amdgcn_mfma_f32_32x32x16_bf16(a00, pb0, o0, 0, 0, 0); o1 = __builtin_amdgcn_mfma_f32_32x32x16_bf16(a01, pb0, o1, 0, 0, 0);
                o0 = __builtin_amdgcn_mfma_f32_32x32x16_bf16(a10, pb1, o0, 0, 0, 0); o1 = __builtin_amdgcn_mfma_f32_32x32x16_bf16(a11, pb1, o1, 0, 0, 0);
            }
        }
    }
}
__device__ __forceinline__ void attn_unit(const bf16* P1, const bf16* Vt, bf16* Y, int b, int h, int qb, LAS unsigned char* lds) {
    int tid_ = threadIdx.x; asm volatile("" : "+v"(tid_)); const int tid = tid_, lane = tid & 63, wid = __builtin_amdgcn_readfirstlane(tid >> 6);
    const int n = lane & 31, hh = lane >> 5;
    const int Q0 = qb * 256, q0 = Q0 + wid * 32, t = q0 + n;
    const size_t rowbase = (size_t)b * SEQ;
    constexpr int RS = 144, KB_BYTES = 64 * RS, ABUF = 2 * KB_BYTES;
    bf16x8 bq[4];
    { const bf16* qp = P1 + (rowbase + t) * 2048 + 1024 + h * 64 + 8 * hh;
#pragma unroll
      for (int c = 0; c < 4; ++c) bq[c] = *(const bf16x8*)(qp + 16 * c); }
    f32x16 o0, o1;
#pragma unroll
    for (int i = 0; i < 16; ++i) { o0[i] = 0.f; o1[i] = 0.f; }
    float R = 1.0f;
    SbK sk; sk.c0 = 0.0f; sk.c1 = 1.0f; sk.cm = -1.0f; asm volatile("" : "+v"(sk.c0), "+v"(sk.c1), "+v"(sk.cm));
    const int ntiles = (Q0 + 256) / 64;
    const int srow = tid >> 3, sch = tid & 7;
    const bf16* kg = P1 + (rowbase + srow) * 2048 + 1536 + h * 64 + sch * 8;
    const bf16* vg = Vt + (size_t)(h * 64 + srow) * TOK + rowbase + sch * 8;
    const int soff = srow * RS + sch * 16;
    const int pin = (n & 0x13) | ((n & 8) >> 1) | ((n & 4) << 1);
#define KLOAD(kt_) (*(const v4u*)(kg + (size_t)(64 * (kt_)) * 2048))
#define VLOAD(kt_) (*(const v4u*)(vg + 64 * (kt_)))
    v4u kA = KLOAD(ntiles - 1), vA = VLOAD(ntiles - 1);
    v4u kB = KLOAD(ntiles - 2), vB = VLOAD(ntiles - 2);
    *(LAS v4u*)(lds + soff) = kA; *(LAS v4u*)(lds + KB_BYTES + soff) = vA;
    __syncthreads();
    LAS unsigned* flags = (LAS unsigned*)(lds + 2 * ABUF);
    bool alive = true;
    for (int kt = ntiles - 1; kt >= 0; kt -= 2) {
        { const int kp2 = kt >= 2 ? kt - 2 : 0; kA = KLOAD(kp2); vA = VLOAD(kp2); }
        if (alive) { attn_tile(lds, lds + KB_BYTES, bq, kt * 64, q0, t, n, hh, pin, o0, o1, R, sk); alive = __builtin_amdgcn_ballot_w64(R != 0.0f) != 0ull; }
        if (lane == 0) flags[wid] = alive ? 1u : 0u;
        *(LAS v4u*)(lds + ABUF + soff) = kB; *(LAS v4u*)(lds + ABUF + KB_BYTES + soff) = vB;
        __syncthreads();
        if (__builtin_amdgcn_ballot_w64(flags[lane & 7] != 0u) == 0ull) break;
        { const int kp3 = kt >= 3 ? kt - 3 : 0; kB = KLOAD(kp3); vB = VLOAD(kp3); }
        if (alive) { attn_tile(lds + ABUF, lds + ABUF + KB_BYTES, bq, (kt - 1) * 64, q0, t, n, hh, pin, o0, o1, R, sk); alive = __builtin_amdgcn_ballot_w64(R != 0.0f) != 0ull; }
        if (lane == 0) flags[8 + wid] = alive ? 1u : 0u;
        if (kt >= 2) { *(LAS v4u*)(lds + soff) = kA; *(LAS v4u*)(lds + KB_BYTES + soff) = vA; }
        __syncthreads();
        if (__builtin_amdgcn_ballot_w64(flags[8 + (lane & 7)] != 0u) == 0ull) break;
    }
    __syncthreads();
#undef KLOAD
#undef VLOAD
    bf16* yp = Y + (rowbase + t) * 1024 + 512 + h * 64 + 4 * hh;
#pragma unroll
    for (int g = 0; g < 4; ++g) {
        v2u w0; w0.x = pk2(o0[4 * g], o0[4 * g + 1]); w0.y = pk2(o0[4 * g + 2], o0[4 * g + 3]);
        v2u w1; w1.x = pk2(o1[4 * g], o1[4 * g + 1]); w1.y = pk2(o1[4 * g + 2], o1[4 * g + 3]);
        *(v2u*)(yp + 8 * g) = w0; *(v2u*)(yp + 32 + 8 * g) = w1;
    }
}

__device__ __forceinline__ void phase_mixer0(const Args& A, LAS unsigned char* lds, int G) {
    const bf16* P1 = (const bf16*)(A.ws + WS_R1); const bf16* Vt = (const bf16*)(A.ws + WS_VT); bf16* Y = (bf16*)(A.ws + WS_H);
    for (int p = blockIdx.x; p < 256; p += G) {
        const int x = p & 7, i = p >> 3, b = x >> 1, h = i >> 2, jq = i & 3, qb0 = 8 * (x & 1);
        attn_unit(P1, Vt, Y, b, h, qb0 + 7 - jq, lds);
        attn_unit(P1, Vt, Y, b, h, qb0 + jq, lds);
    }
    __syncthreads();
    sgu_phase(P1, Y, A.in[10], A.in[11], A.in[12], lds, G);
}

__device__ __forceinline__ void phase_conv(const Args& A, int G) {
    const bf16* PS = (const bf16*)(A.ws + WS_R1); bf16* Y = (bf16*)(A.ws + WS_H); const float* cw = A.in[14];
    int tid_ = threadIdx.x; asm volatile("" : "+v"(tid_)); const int tid = tid_, cgp = tid & 127, sub = tid >> 7, ch0 = cgp * 8;
    float w0[8], w1[8], w2[8];
#pragma unroll
    for (int i = 0; i < 8; ++i) { w0[i] = cw[ch0 + i]; w1[i] = cw[1024 + ch0 + i]; w2[i] = cw[2048 + ch0 + i]; }
    const bool aff = (G == 256); const int cbx = blockIdx.x; const int cnit = aff ? 2 : (cbx < TOK / 32 ? (TOK / 32 - cbx + G - 1) / G : 0);
    for (int cit = 0; cit < cnit; ++cit) { const int unit = aff ? 64 * (cbx & 7) + 2 * (cbx >> 3) + cit : cbx + cit * G;
        const int r0 = unit * 32 + sub * 8; const bool halo = (r0 & (SEQ - 1)) != 0;
        float pm2[8], pm1[8];
#pragma unroll
        for (int i = 0; i < 8; ++i) { pm2[i] = 0.f; pm1[i] = 0.f; }
        if (halo) {
            const v4u c2 = *(const v4u*)(PS + (size_t)(r0 - 2) * 3072 + 1024 + ch0), x2 = *(const v4u*)(PS + (size_t)(r0 - 2) * 3072 + 2048 + ch0);
            const v4u c1 = *(const v4u*)(PS + (size_t)(r0 - 1) * 3072 + 1024 + ch0), x1 = *(const v4u*)(PS + (size_t)(r0 - 1) * 3072 + 2048 + ch0);
            pm2[0] = bflo(c2.x) * bflo(x2.x); pm2[1] = bfhi(c2.x) * bfhi(x2.x); pm2[2] = bflo(c2.y) * bflo(x2.y); pm2[3] = bfhi(c2.y) * bfhi(x2.y);
            pm2[4] = bflo(c2.z) * bflo(x2.z); pm2[5] = bfhi(c2.z) * bfhi(x2.z); pm2[6] = bflo(c2.w) * bflo(x2.w); pm2[7] = bfhi(c2.w) * bfhi(x2.w);
            pm1[0] = bflo(c1.x) * bflo(x1.x); pm1[1] = bfhi(c1.x) * bfhi(x1.x); pm1[2] = bflo(c1.y) * bflo(x1.y); pm1[3] = bfhi(c1.y) * bfhi(x1.y);
            pm1[4] = bflo(c1.z) * bflo(x1.z); pm1[5] = bfhi(c1.z) * bfhi(x1.z); pm1[6] = bflo(c1.w) * bflo(x1.w); pm1[7] = bfhi(c1.w) * bfhi(x1.w);
        }
        v4u bgv[8], cgv8[8], xv8[8];
#pragma unroll
        for (int i = 0; i < 8; ++i) { const bf16* rp = PS + (size_t)(r0 + i) * 3072 + ch0; bgv[i] = *(const v4u*)rp; cgv8[i] = *(const v4u*)(rp + 1024); xv8[i] = *(const v4u*)(rp + 2048); }
#pragma unroll
        for (int i = 0; i < 8; ++i) {
            const v4u bg = bgv[i], cgv = cgv8[i], xv = xv8[i];
            float p[8], bgf[8], y[8];
            p[0] = bflo(cgv.x) * bflo(xv.x); p[1] = bfhi(cgv.x) * bfhi(xv.x); p[2] = bflo(cgv.y) * bflo(xv.y); p[3] = bfhi(cgv.y) * bfhi(xv.y);
            p[4] = bflo(cgv.z) * bflo(xv.z); p[5] = bfhi(cgv.z) * bfhi(xv.z); p[6] = bflo(cgv.w) * bflo(xv.w); p[7] = bfhi(cgv.w) * bfhi(xv.w);
            bgf[0] = bflo(bg.x); bgf[1] = bfhi(bg.x); bgf[2] = bflo(bg.y); bgf[3] = bfhi(bg.y); bgf[4] = bflo(bg.z); bgf[5] = bfhi(bg.z); bgf[6] = bflo(bg.w); bgf[7] = bfhi(bg.w);
#pragma unroll
            for (int c = 0; c < 8; ++c) { y[c] = bgf[c] * (w0[c] * pm2[c] + w1[c] * pm1[c] + w2[c] * p[c]); pm2[c] = pm1[c]; pm1[c] = p[c]; }
            v4u o; o.x = pk2(y[0], y[1]); o.y = pk2(y[2], y[3]); o.z = pk2(y[4], y[5]); o.w = pk2(y[6], y[7]);
            *(v4u*)(Y + (size_t)(r0 + i) * 1024 + ch0) = o;
        }
    }
}

constexpr int N_PHASES = 17;
__global__ void __launch_bounds__(NTHR, 2) mega_fwd(Args A) {
    extern __shared__ __attribute__((aligned(16))) unsigned char lds_raw[];
    LAS unsigned char* lds = (LAS unsigned char*)lds_raw;
    cg::grid_group grid = cg::this_grid();
    const int G = gridDim.x;
    volatile LAS unsigned* bst = (volatile LAS unsigned*)(lds + 131072);
    if (threadIdx.x < 2) bst[threadIdx.x] = 0u;
    __syncthreads();
    XcdBarrier xbar = xcd_barrier_post((unsigned*)(A.ws + WS_BAR), bst);
    if (A.hi > 1000) grid.sync();
    for (int p = A.lo; p < A.hi; ++p) {
      for (int rep = 0; rep <= (((PROBE_MASK >> p) & 1) ? PROBE_N : 0); ++rep) {
        if (rep) __syncthreads();
        size_t zoff = 0; asm volatile("" : "+s"(zoff));
        unsigned char* ws = A.ws + zoff;
        float* X = A.out + zoff;
        const float* MOD = (const float*)(ws + WS_MOD);
        float* SSQ = (float*)(ws + WS_SSQ);
        const float* BIAS = (const float*)(ws + WS_BIAS);
        bf16* HA = (bf16*)(ws + WS_H); bf16* HB = (bf16*)(ws + WS_HB); bf16* XB = (bf16*)(ws + WS_XB);
        if (p == 0) phase_prologue(A, lds, G);
        else if (p == 1) { phase_norm0(A.in[0], A.in[4], MOD + DM, HA, XB, SSQ, G); phase_bias(ws, G); }
        else if (p == 16) phase_final_norm(XB, X, A.in[16], SSQ + 6 * TOK, G);
        else {
            const int q = p - 2, L = q / 7, r = q % 7, s = (r < 2) ? 0 : (r < 5 ? 1 : 2), j = L * 3 + s;
            const float* modL = MOD + (size_t)L * 4 * MODLD;
            const float* ssqj = SSQ + (size_t)j * TOK;
            if (r == 0 || r == 5) {
                const int f = L * 2 + (s >> 1);
                pg8::Gemm g{r == 5 ? HB : HA, (const bf16*)(ws + WS_WGU) + (size_t)f * 5632 * 1024, TOK, 5632, DM}; pg8::StaticOrder S; S.init(TOK, 5632, G, (int)blockIdx.x);
                pg8::EpiSwiGLU E{(bf16*)(ws + WS_R1), FF, ssqj, BIAS + (size_t)f * 4 * 5632};
                pg8::gemm_phase<pg8::EpiSwiGLU, pg8::StaticOrder, true, true>(lds, g, S, E);
                if (!rep) filler(A, ws, lds, p, G);
            } else if (r == 2) {
                {
                    const int N = (L == 0) ? 2048 : 3072;
                    const pg8::Gemm g{HA, (const bf16*)(ws + (L == 0 ? WS_WHYIN : WS_WSCIN)), TOK, N, DM};
                    const pg8::EpiBf16G<false> E{(bf16*)(ws + WS_R1), N, (L == 0) ? 4 : 0, ssqj, BIAS + (L == 0 ? BIAS_IN0 : BIAS_IN1), (L == 0) ? 2560 : 3072};
                    pg8::StaticOrder S; S.init(g.M, g.N, G, (int)blockIdx.x);
                    pg8::gemm_phase<pg8::EpiBf16G<false>, pg8::StaticOrder, true, true>(lds, g, S, E);
                }
                if (L == 0) {
                    pg8::Gemm g{(const bf16*)(ws + WS_WHYIN) + (size_t)2048 * 1024, HA, 512, TOK, DM}; pg8::StaticOrder S; S.init(512, TOK, G, (int)blockIdx.x);
                    pg8::EpiBf16G<true> E{(bf16*)(ws + WS_VT), TOK, 0, ssqj, BIAS + BIAS_IN0 + 2048, 2560};
                    pg8::gemm_phase<pg8::EpiBf16G<true>, pg8::StaticOrder, true, true>(lds, g, S, E);
                    if (!rep) filler(A, ws, lds, p, G);
                }
            } else if (r == 3) {
                if (L == 0) phase_mixer0(A, lds, G); else phase_conv(A, G);
            } else {
                const int jn = j + 1, jc = jn > 5 ? 5 : jn, Ln = jc / 3, sn = jc % 3;
                const float* gn = A.in[4] + (size_t)jc * DM; const int goff = L * 4 * MODLD + (3 * s + 2) * DM, soff = Ln * 4 * MODLD + (3 * sn + 1) * DM;
                float* ssqn = SSQ + (size_t)jn * TOK;
                const bool dn = (s != 1); const int f = L * 2 + (s >> 1);
                const bf16* Ap = dn ? (const bf16*)(ws + WS_R1) : HA;
                const bf16* Bp = dn ? (const bf16*)(ws + WS_WD) + (size_t)f * 1024 * FF : (const bf16*)(ws + (L == 0 ? WS_WHYOUT : WS_WSCOUT));
                const pg8::Gemm g{Ap, Bp, TOK, DM, dn ? FF : DM};
                const pg8::EpiResid E{XB, XB, MOD, rep ? -98304 : goff, soff, dn ? HA : HB, gn, rep ? SSQ + 7 * TOK : ssqn};
                pg8::StaticOrder S; S.init(TOK, DM, G, (int)blockIdx.x);
                pg8::gemm_phase<pg8::EpiResid, pg8::StaticOrder, true, true>(lds, g, S, E);
            }
        }
      }
        if (p + 1 < A.hi) xcd_barrier(xbar);
    }
}

extern "C" void kernel_launch(void* const* d_in, const int* in_sizes, int n_in, void* d_out, int out_size, void* d_ws, size_t ws_size, hipStream_t stream) {
    static int grid = 0;
    if (grid == 0) {
        if (n_in != 17 || out_size != TOK * DM || ws_size < WS_END) { fprintf(stderr, "kernel_launch: unexpected shapes (n_in %d out %d ws %zu)\n", n_in, out_size, ws_size); grid = -1; return; }
        int dev = 0, cus = 0, per_cu = 0;
        (void)hipGetDevice(&dev); (void)hipDeviceGetAttribute(&cus, hipDeviceAttributeMultiprocessorCount, dev);
        if (hipFuncSetAttribute((const void*)mega_fwd, hipFuncAttributeMaxDynamicSharedMemorySize, LDS_BYTES) != hipSuccess) { fprintf(stderr, "kernel_launch: hipFuncSetAttribute failed\n"); grid = -1; return; }
        if (hipOccupancyMaxActiveBlocksPerMultiprocessor(&per_cu, (const void*)mega_fwd, NTHR, LDS_BYTES) != hipSuccess || per_cu < 1) { fprintf(stderr, "kernel_launch: occupancy query gave %d\n", per_cu); per_cu = 1; }
        (void)hipGetLastError();
        grid = cus * 1;
    }
    if (grid < 0) return;
    if (hipMemsetAsync(d_ws, 0, CTL_ZERO_BYTES, stream) != hipSuccess) { fprintf(stderr, "kernel_launch: memset failed\n"); return; }
    Args a{};
    for (int i = 0; i < 17; ++i) a.in[i] = (const float*)d_in[i];
    a.out = (float*)d_out; a.ws = (unsigned char*)d_ws;
    a.lo = 0; a.hi = N_PHASES; void* kargs[] = {&a};
    hipError_t e = hipLaunchCooperativeKernel((const void*)mega_fwd, dim3(grid), dim3(NTHR), kargs, LDS_BYTES, stream);
    if (e != hipSuccess) fprintf(stderr, "cooperative launch failed: %s (grid %d)\n", hipGetErrorString(e), grid);
}
```

```cpp
#include <hip/hip_runtime.h>
#include <hip/hip_cooperative_groups.h>
#include <cstdio>
#include <cstdint>
namespace cg = cooperative_groups;
namespace pg8 {
#define PG8_LAS __attribute__((address_space(3)))
typedef unsigned short bf16_t;
typedef short bf16x8 __attribute__((ext_vector_type(8)));
typedef float f32x4 __attribute__((ext_vector_type(4)));
typedef unsigned u32x4 __attribute__((ext_vector_type(4)));
constexpr int BM = 256, BK = 64, HALF = 128, HTB = HALF * BK * 2  , STAGE_BYTES = 8 * HTB, NXCD = 8, WGM = 8;

__host__ __device__ __forceinline__ int lds_byte(int r, int c) { const int st = (r >> 4) * 2 + (c >> 5), rr = r & 15, cc = c & 31, ob = rr * 64 + cc * 2; return st * 1024 + (ob ^ (((ob >> 9) & 1) << 5)); }
__host__ __device__ __forceinline__ void stage_rc(int b, int& R, int& C) { const int st = b / 1024, sb = b % 1024, swz = sb ^ (((sb >> 9) & 1) << 5); R = (st >> 1) * 16 + swz / 64; C = (st & 1) * 32 + (swz % 64) / 2; }
__host__ __device__ __forceinline__ int perm32(int rho) { const int n = rho >> 4, i = rho & 15; return 8 * (i >> 2) + 4 * n + (i & 3); }

struct Unit { int pm, pn; };
struct Gemm { const bf16_t* A; const bf16_t* Bt; int M, N, K; };

struct StaticOrder {
    int nM, nN, nwg, G, c;
    __host__ __device__ void init(int M, int N, int G_, int c_) { nM = M / BM; nN = N / BM; nwg = nM * nN; G = G_; c = c_; }
    __host__ __device__ bool next(int i, Unit& u) const {
        const long L = (long)i * G + c; if (L >= nwg) return false;
        int wgid = (int)L; { const int q = nwg / NXCD, r = nwg % NXCD, xcd = wgid % NXCD, off = wgid / NXCD; wgid = (xcd < r ? xcd * (q + 1) : r * (q + 1) + (xcd - r) * q) + off; }
        const int nig = WGM * nN, gid = wgid / nig, fm = gid * WGM, gsz = (nM - fm) < WGM ? (nM - fm) : WGM;
        u.pm = fm + ((wgid % nig) % gsz); u.pn = (wgid % nig) / gsz; return true;
    }
    __device__ __forceinline__ void a_ready(const Unit&) const {}
    __device__ __forceinline__ void done(const Unit&) const {}
};

__device__ __forceinline__ unsigned cvt_pk_bf16(float lo, float hi) { unsigned r; asm volatile("v_cvt_pk_bf16_f32 %0, %1, %2" : "=v"(r) : "v"(lo), "v"(hi)); return r; }
typedef float f32x2 __attribute__((ext_vector_type(2)));
__device__ __forceinline__ f32x2 gelu_pk(f32x2 v) {
    const f32x2 av = __builtin_elementwise_abs(v), d = av * 0.2316418882f + 1.0f;
    f32x2 t; t.x = __builtin_amdgcn_rcpf(d.x); t.y = __builtin_amdgcn_rcpf(d.y);
    f32x2 q = t * 0.5307027145f + (-0.7265760135f); q = q * t + 0.7107068705f; q = q * t + (-0.142248368f); q = q * t + 0.127414796f; q = q * t;
    const f32x2 s = (v * v) * (-0.72134752044f);
    f32x2 e; e.x = __builtin_amdgcn_exp2f(s.x); e.y = __builtin_amdgcn_exp2f(s.y);
    const f32x2 m = v * (q * e), r = v - m;
    f32x2 o; o.x = v.x < 0.f ? m.x : r.x; o.y = v.y < 0.f ? m.y : r.y; return o;
}

__device__ __forceinline__ float silu_f(float g) { return g * __builtin_amdgcn_rcpf(1.0f + __builtin_amdgcn_exp2f(-1.44269504f * g)); }
__device__ __forceinline__ float rstd_of(float ssq) { return __builtin_amdgcn_rsqf(ssq * (1.0f / 1024.0f) + 1e-6f); }
struct EpiSwiGLU {
    static constexpr bool PERM = true, AFTER_DRAIN = false;
    bf16_t* O; int ldc; const float* ssq; const float* bias;
    __device__ __forceinline__ void operator()(const f32x4 (&acc)[2][2][4][2], const Unit& u, int wr, int wc, int fr, int fq) const {
        const int row0 = u.pm * BM + wr * 64 + fr, col0 = u.pn * HALF + wc * 32 + 8 * fq;
        const float* bp = bias + (size_t)((u.pm * BM) >> 12) * 5632 + u.pn * BM + wc * 32 + 8 * fq;
        const f32x4 bg0 = *(const f32x4*)bp, bg1 = *(const f32x4*)(bp + 4), bu0 = *(const f32x4*)(bp + HALF), bu1 = *(const f32x4*)(bp + HALF + 4);
        float sq8[2][4];
#pragma unroll
        for (int ai = 0; ai < 2; ++ai)
#pragma unroll
            for (int m = 0; m < 4; ++m) sq8[ai][m] = ssq[row0 + ai * HALF + m * 16];
#pragma unroll
        for (int ai = 0; ai < 2; ++ai)
#pragma unroll
            for (int m = 0; m < 4; ++m) { const int row = row0 + ai * HALF + m * 16; bf16_t* rowp = O + (size_t)row * ldc + col0;
                const float rs = rstd_of(sq8[ai][m]);
                const f32x4 g0 = acc[ai][0][m][0] * rs + bg0, g1 = acc[ai][0][m][1] * rs + bg1, u0 = acc[ai][1][m][0] * rs + bu0, u1 = acc[ai][1][m][1] * rs + bu1;
                u32x4 w; w.x = cvt_pk_bf16(silu_f(g0[0]) * u0[0], silu_f(g0[1]) * u0[1]); w.y = cvt_pk_bf16(silu_f(g0[2]) * u0[2], silu_f(g0[3]) * u0[3]);
                w.z = cvt_pk_bf16(silu_f(g1[0]) * u1[0], silu_f(g1[1]) * u1[1]); w.w = cvt_pk_bf16(silu_f(g1[2]) * u1[2], silu_f(g1[3]) * u1[3]);
                *(u32x4*)rowp = w; }
    }
};
template <bool TR> struct EpiBf16G {
    static constexpr bool PERM = true, AFTER_DRAIN = false;
    bf16_t* O; int ldc; int gelu_tiles; const float* ssq; const float* bias; int bpitch;
    __device__ __forceinline__ void operator()(const f32x4 (&acc)[2][2][4][2], const Unit& u, int wr, int wc, int fr, int fq) const {
        const int row0 = u.pm * BM + wr * 64 + fr, col0 = u.pn * BM + wc * 32 + 8 * fq; const bool ge = u.pn < gelu_tiles, qs = gelu_tiles != 0 && (u.pn == 4 || u.pn == 5);
        f32x4 cv[2][2];
        const float* bp = bias + (size_t)(((TR ? u.pn : u.pm) * BM) >> 12) * bpitch;
#pragma unroll
        for (int bj = 0; bj < 2; ++bj)
#pragma unroll
            for (int n = 0; n < 2; ++n) {
                if (TR) { const f32x4 q = *(const f32x4*)(ssq + col0 + bj * HALF + 4 * n); cv[bj][n] = (f32x4){rstd_of(q[0]), rstd_of(q[1]), rstd_of(q[2]), rstd_of(q[3])}; }
                else cv[bj][n] = *(const f32x4*)(bp + col0 + bj * HALF + 4 * n);
            }
        float rv8[2][4];
#pragma unroll
        for (int ai = 0; ai < 2; ++ai)
#pragma unroll
            for (int m = 0; m < 4; ++m) { const int row = row0 + ai * HALF + m * 16; rv8[ai][m] = TR ? bp[row] : ssq[row]; }
#pragma unroll
        for (int ai = 0; ai < 2; ++ai)
#pragma unroll
            for (int m = 0; m < 4; ++m) { const int row = row0 + ai * HALF + m * 16; bf16_t* rowp = O + (size_t)row * ldc + col0;
                const float rv = TR ? rv8[ai][m] : rstd_of(rv8[ai][m]);
#pragma unroll
                for (int bj = 0; bj < 2; ++bj) { f32x4 v0, v1;
                    if (TR) { v0 = acc[ai][bj][m][0] * cv[bj][0] + rv; v1 = acc[ai][bj][m][1] * cv[bj][1] + rv; }
                    else { v0 = acc[ai][bj][m][0] * rv + cv[bj][0]; v1 = acc[ai][bj][m][1] * rv + cv[bj][1]; }
                    if (ge) { f32x2 a = gelu_pk((f32x2){v0[0], v0[1]}), b = gelu_pk((f32x2){v0[2], v0[3]}), c = gelu_pk((f32x2){v1[0], v1[1]}), d = gelu_pk((f32x2){v1[2], v1[3]});
                        v0 = (f32x4){a.x, a.y, b.x, b.y}; v1 = (f32x4){c.x, c.y, d.x, d.y}; }
                    if (!TR && qs) { v0 = v0 * (-0.125f * 1.44269504f); v1 = v1 * (-0.125f * 1.44269504f); }
                    u32x4 w; w.x = cvt_pk_bf16(v0[0], v0[1]); w.y = cvt_pk_bf16(v0[2], v0[3]); w.z = cvt_pk_bf16(v1[0], v1[1]); w.w = cvt_pk_bf16(v1[2], v1[3]);
                    *(u32x4*)(rowp + bj * HALF) = w; } }
    }
};
struct EpiResid {
    static constexpr bool PERM = true, AFTER_DRAIN = false;
    const bf16_t* xin; bf16_t* xout; const float* mod; int goff, soff; bf16_t* XS; const float* gn; float* ssq;
    template <int AI, int M0> __device__ __forceinline__ void ld(u32x4 (&r)[2][2], int row0, int col0) const {
#pragma unroll
        for (int m = 0; m < 2; ++m)
#pragma unroll
            for (int bj = 0; bj < 2; ++bj) r[m][bj] = *(const u32x4*)(xin + (size_t)(row0 + AI * HALF + (M0 + m) * 16) * 1024 + col0 + bj * HALF);
    }
    template <int AI, int M0> __device__ __forceinline__ void cp(f32x4 (&y)[2][2][2], const u32x4 (&r)[2][2], const f32x4 (&acc)[2][2][4][2], const f32x4 (&gv)[2][2]) const {
#pragma unroll
        for (int m = 0; m < 2; ++m)
#pragma unroll
            for (int bj = 0; bj < 2; ++bj) { const u32x4 q = r[m][bj];
                const f32x4 x0 = {__uint_as_float(q.x << 16), __uint_as_float(q.x & 0xffff0000u), __uint_as_float(q.y << 16), __uint_as_float(q.y & 0xffff0000u)};
                const f32x4 x1 = {__uint_as_float(q.z << 16), __uint_as_float(q.z & 0xffff0000u), __uint_as_float(q.w << 16), __uint_as_float(q.w & 0xffff0000u)};
                y[m][bj][0] = x0 + gv[bj][0] * acc[AI][bj][M0 + m][0]; y[m][bj][1] = x1 + gv[bj][1] * acc[AI][bj][M0 + m][1]; }
    }
    template <int AI, int M0> __device__ __forceinline__ void st(const f32x4 (&y)[2][2][2], const f32x4 (&gs)[2][2], int row0, int col0, int fq) const {
#pragma unroll
        for (int m = 0; m < 2; ++m) { const int row = row0 + AI * HALF + (M0 + m) * 16; float sq = 0.f;
#pragma unroll
            for (int bj = 0; bj < 2; ++bj) { const size_t off = (size_t)row * 1024 + col0 + bj * HALF; const f32x4 y0 = y[m][bj][0], y1 = y[m][bj][1];
                u32x4 xw; xw.x = cvt_pk_bf16(y0[0], y0[1]); xw.y = cvt_pk_bf16(y0[2], y0[3]); xw.z = cvt_pk_bf16(y1[0], y1[1]); xw.w = cvt_pk_bf16(y1[2], y1[3]);
                *(u32x4*)(xout + off) = xw;
                sq += (y0[0] * y0[0] + y0[1] * y0[1]) + (y0[2] * y0[2] + y0[3] * y0[3]) + (y1[0] * y1[0] + y1[1] * y1[1]) + (y1[2] * y1[2] + y1[3] * y1[3]);
                const f32x4 s0 = y0 * gs[bj][0], s1 = y1 * gs[bj][1];
                u32x4 w; w.x = cvt_pk_bf16(s0[0], s0[1]); w.y = cvt_pk_bf16(s0[2], s0[3]); w.z = cvt_pk_bf16(s1[0], s1[1]); w.w = cvt_pk_bf16(s1[2], s1[3]);
                *(u32x4*)(XS + off) = w; }
            sq += __shfl_xor(sq, 16); sq += __shfl_xor(sq, 32);
            if (fq == 0) (void)__hip_atomic_fetch_add(ssq + row, sq, __ATOMIC_RELAXED, __HIP_MEMORY_SCOPE_AGENT); }
    }
    __device__ __forceinline__ void operator()(const f32x4 (&acc)[2][2][4][2], const Unit& u, int wr, int wc, int fr, int fq) const {
        const int row0 = u.pm * BM + wr * 64 + fr, col0 = u.pn * BM + wc * 32 + 8 * fq; const float* mb = mod + (size_t)((u.pm * BM) >> 12) * 9216 + col0;
        u32x4 ra[2][2], rb[2][2]; f32x4 y[2][2][2];
        ld<0, 0>(ra, row0, col0);
        f32x4 gv[2][2], gs[2][2];
#pragma unroll
        for (int bj = 0; bj < 2; ++bj)
#pragma unroll
            for (int n = 0; n < 2; ++n) { gv[bj][n] = *(const f32x4*)(mb + goff + bj * HALF + 4 * n);
                gs[bj][n] = *(const f32x4*)(gn + col0 + bj * HALF + 4 * n) * (*(const f32x4*)(mb + soff + bj * HALF + 4 * n) + 1.0f); }
        cp<0, 0>(y, ra, acc, gv); ld<0, 2>(rb, row0, col0); st<0, 0>(y, gs, row0, col0, fq);
        cp<0, 2>(y, rb, acc, gv); ld<1, 0>(ra, row0, col0); st<0, 2>(y, gs, row0, col0, fq);
        cp<1, 0>(y, ra, acc, gv); ld<1, 2>(rb, row0, col0); st<1, 0>(y, gs, row0, col0, fq);
        cp<1, 2>(y, rb, acc, gv); st<1, 2>(y, gs, row0, col0, fq);
    }
};

template <class Epi, class Sched, bool ALIGN_EPI = false, bool SP2 = false>
__device__ __forceinline__ void gemm_phase(PG8_LAS unsigned char* lds, const Gemm g, const Sched& S, const Epi& E) {
    int tid_ = threadIdx.x; asm volatile("" : "+v"(tid_)); const int tid = tid_, wid = __builtin_amdgcn_readfirstlane(tid >> 6), lane = tid & 63, wr = wid >> 2, wc = wid & 3, fr = lane & 15, fq = lane >> 4;
    const int K = g.K, nt = K / BK;
    unsigned voffA[2], voffB[2];
#pragma unroll
    for (int i = 0; i < 2; ++i) { int R, C; stage_rc(tid * 16 + i * 8192, R, C); const int Rb = Epi::PERM ? ((R & ~31) + perm32(R & 31)) : R;
        voffA[i] = (unsigned)(R * K + C) * 2u; voffB[i] = (unsigned)(Rb * K + C) * 2u; }
    const size_t kstep = (size_t)(BK * 2);
    const size_t hstep = (size_t)HALF * K * 2;
    const size_t tstep = 2 * hstep;
    const unsigned ldsw = (unsigned)wid * 1024u;
    const int aoff = lds_byte(wr * 64 + fr, fq * 8), boff = lds_byte(wc * 32 + fr, fq * 8);
#define PG8_SA(b, h) (((b) * 2 + (h)) * HTB)
#define PG8_SB(b, h) ((4 + (b) * 2 + (h)) * HTB)
#define PG8_STAGE(bufoff, gbase, voff) do { _Pragma("unroll") for (int _i = 0; _i < 2; ++_i) \
        __builtin_amdgcn_global_load_lds((const unsigned*)((const char*)(gbase) + (voff)[_i]), (PG8_LAS unsigned*)(lds + (bufoff) + ldsw + _i * 8192), 16, 0, 0); } while (0)
#define PG8_LDA(dst, b, h) do { _Pragma("unroll") for (int m = 0; m < 4; ++m) _Pragma("unroll") for (int k = 0; k < 2; ++k) dst[m][k] = *(const PG8_LAS bf16x8*)(lds + PG8_SA(b, h) + aoff + m * 2048 + k * 1024); } while (0)
#define PG8_LDB(dst, b, h) do { _Pragma("unroll") for (int n = 0; n < 2; ++n) _Pragma("unroll") for (int k = 0; k < 2; ++k) dst[n][k] = *(const PG8_LAS bf16x8*)(lds + PG8_SB(b, h) + boff + n * 2048 + k * 1024); } while (0)
#define PG8_MMA(ai, bj, At, Bt) do { __builtin_amdgcn_s_setprio(1); _Pragma("unroll") for (int m = 0; m < 4; ++m) _Pragma("unroll") for (int n = 0; n < 2; ++n) _Pragma("unroll") for (int k = 0; k < 2; ++k) \
        acc[ai][bj][m][n] = __builtin_amdgcn_mfma_f32_16x16x32_bf16(Bt[n][k], At[m][k], acc[ai][bj][m][n], 0, 0, 0); __builtin_amdgcn_s_setprio(0); } while (0)
#define PG8_WAIT_V(n) asm volatile("s_waitcnt vmcnt(" #n ")" ::: "memory")
#define PG8_WAIT_L(n) asm volatile("s_waitcnt lgkmcnt(" #n ")" ::: "memory")
#define PG8_BAR __builtin_amdgcn_s_barrier()
#define PG8_SCHED __builtin_amdgcn_sched_barrier(0)
    Unit cur, nxt; int ui = 0;
    if (!S.next(0, cur)) return;
    f32x4 acc[2][2][4][2];
#pragma unroll
    for (int a = 0; a < 2; ++a)
#pragma unroll
        for (int b = 0; b < 2; ++b)
#pragma unroll
            for (int m = 0; m < 4; ++m)
#pragma unroll
                for (int n = 0; n < 2; ++n) acc[a][b][m][n] = (f32x4){0.f, 0.f, 0.f, 0.f};
    bf16x8 At[4][2], B0[2][2], B1[2][2];
    const char* cA = (const char*)g.A + (size_t)cur.pm * tstep; const char* cB = (const char*)g.Bt + (size_t)cur.pn * tstep;
    S.a_ready(cur);
    if constexpr (SP2) {
        PG8_STAGE(PG8_SB(0, 0), cB, voffB); PG8_STAGE(PG8_SB(0, 1), cB + hstep, voffB); PG8_STAGE(PG8_SA(0, 0), cA, voffA); PG8_STAGE(PG8_SA(0, 1), cA + hstep, voffA);
        if (wr == 1) PG8_BAR;
        PG8_WAIT_V(2); PG8_BAR;
        PG8_STAGE(PG8_SB(1, 0), cB + kstep, voffB); PG8_STAGE(PG8_SA(1, 0), cA + kstep, voffA); PG8_STAGE(PG8_SB(1, 1), cB + hstep + kstep, voffB);
        PG8_WAIT_V(6); PG8_BAR;
    } else {
        PG8_STAGE(PG8_SB(0, 0), cB, voffB); PG8_STAGE(PG8_SA(0, 0), cA, voffA); PG8_STAGE(PG8_SB(0, 1), cB + hstep, voffB); PG8_STAGE(PG8_SA(0, 1), cA + hstep, voffA);
        if (wr == 1) PG8_BAR;
        PG8_WAIT_V(4); PG8_BAR;
        PG8_STAGE(PG8_SB(1, 0), cB + kstep, voffB); PG8_STAGE(PG8_SA(1, 0), cA + kstep, voffA); PG8_STAGE(PG8_SB(1, 1), cB + hstep + kstep, voffB);
        PG8_WAIT_V(6); PG8_BAR;
    }
    for (;;) {
        const bool has_next = S.next(ui + 1, nxt);
        const char* nA = has_next ? (const char*)g.A + (size_t)nxt.pm * tstep : cA; const char* nB = has_next ? (const char*)g.Bt + (size_t)nxt.pn * tstep : cB;
        for (int t = 0; t < nt; t += 2) {
            const bool last = (t == nt - 2);
            const char* a1 = cA + (size_t)(t + 1) * kstep;
            const char* a2 = last ? nA : cA + (size_t)(t + 2) * kstep; const char* b2 = last ? nB : cB + (size_t)(t + 2) * kstep;
            const char* a3 = a2 + kstep; const char* b3 = b2 + kstep;
            if (last && has_next) S.a_ready(nxt);
            if constexpr (SP2) {
            PG8_LDB(B0, 0, 0); PG8_LDB(B1, 0, 1); PG8_SCHED; PG8_LDA(At, 0, 0); PG8_STAGE(PG8_SA(1, 1), a1 + hstep, voffA);
            PG8_WAIT_V(8); PG8_WAIT_L(0); PG8_BAR; PG8_MMA(0, 0, At, B0); PG8_MMA(0, 1, At, B1); PG8_BAR; PG8_SCHED;
            PG8_LDA(At, 0, 1); PG8_STAGE(PG8_SB(0, 0), b2, voffB); PG8_STAGE(PG8_SB(0, 1), b2 + hstep, voffB); PG8_STAGE(PG8_SA(0, 0), a2, voffA);
            PG8_WAIT_V(8); PG8_WAIT_L(0); PG8_BAR; PG8_MMA(1, 0, At, B0); PG8_MMA(1, 1, At, B1); PG8_BAR; PG8_SCHED;
            PG8_LDB(B0, 1, 0); PG8_LDB(B1, 1, 1); PG8_SCHED; PG8_LDA(At, 1, 0); PG8_STAGE(PG8_SA(0, 1), a2 + hstep, voffA);
            PG8_WAIT_V(8); PG8_WAIT_L(0); PG8_BAR; PG8_MMA(0, 0, At, B0); PG8_MMA(0, 1, At, B1); PG8_BAR; PG8_SCHED;
            PG8_LDA(At, 1, 1); PG8_STAGE(PG8_SB(1, 0), b3, voffB); PG8_STAGE(PG8_SB(1, 1), b3 + hstep, voffB); PG8_STAGE(PG8_SA(1, 0), a3, voffA);
            PG8_WAIT_V(8); PG8_WAIT_L(0); PG8_BAR; PG8_MMA(1, 0, At, B0); PG8_MMA(1, 1, At, B1); PG8_BAR; PG8_SCHED;
            } else {
            PG8_LDB(B0, 0, 0); PG8_SCHED; PG8_LDA(At, 0, 0); PG8_STAGE(PG8_SA(1, 1), a1 + hstep, voffA);
            PG8_WAIT_L(8); PG8_BAR; PG8_WAIT_L(0); PG8_MMA(0, 0, At, B0); PG8_BAR; PG8_SCHED;
            PG8_LDB(B1, 0, 1); PG8_STAGE(PG8_SB(0, 0), b2, voffB);
            PG8_BAR; PG8_WAIT_L(0); PG8_MMA(0, 1, At, B1); PG8_BAR;
            PG8_LDA(At, 0, 1); PG8_STAGE(PG8_SA(0, 0), a2, voffA);
            PG8_BAR; PG8_WAIT_L(0); PG8_MMA(1, 0, At, B0); PG8_BAR; PG8_SCHED;
            PG8_STAGE(PG8_SB(0, 1), b2 + hstep, voffB);
            PG8_WAIT_V(6); PG8_BAR; PG8_MMA(1, 1, At, B1); PG8_BAR;
            PG8_LDB(B0, 1, 0); PG8_SCHED; PG8_LDA(At, 1, 0); PG8_STAGE(PG8_SA(0, 1), a2 + hstep, voffA);
            PG8_WAIT_L(8); PG8_BAR; PG8_WAIT_L(0); PG8_MMA(0, 0, At, B0); PG8_BAR; PG8_SCHED;
            PG8_LDB(B1, 1, 1); PG8_STAGE(PG8_SB(1, 0), b3, voffB);
            PG8_BAR; PG8_WAIT_L(0); PG8_MMA(0, 1, At, B1); PG8_BAR;
            PG8_LDA(At, 1, 1); PG8_STAGE(PG8_SA(1, 0), a3, voffA);
            PG8_BAR; PG8_WAIT_L(0); PG8_MMA(1, 0, At, B0); PG8_BAR; PG8_SCHED;
            PG8_STAGE(PG8_SB(1, 1), b3 + hstep, voffB);
            PG8_WAIT_V(6); PG8_BAR; PG8_MMA(1, 1, At, B1); PG8_BAR;
            }
        }
        if constexpr (ALIGN_EPI) { if (wr == 0) PG8_BAR; }
        if constexpr (!Epi::AFTER_DRAIN) { E(acc, cur, wr, wc, fr, fq); S.done(cur); }
        if (!has_next) break;
#pragma unroll
        for (int a = 0; a < 2; ++a)
#pragma unroll
            for (int b = 0; b < 2; ++b)
#pragma unroll
                for (int m = 0; m < 4; ++m)
#pragma unroll
                    for (int n = 0; n < 2; ++n) acc[a][b][m][n] = (f32x4){0.f, 0.f, 0.f, 0.f};
        cur = nxt; cA = nA; cB = nB; ++ui;
        if constexpr (ALIGN_EPI) { if (wr == 1) PG8_BAR; }
    }
    PG8_WAIT_V(0);
    if constexpr (!ALIGN_EPI) { if (wr == 0) PG8_BAR; }
    PG8_BAR;
    if constexpr (Epi::AFTER_DRAIN) { E.fused(acc, cur, wr, wc, fr, fq, lds, wid, lane); S.done(cur); }
#undef PG8_SA
#undef PG8_SB
#undef PG8_STAGE
#undef PG8_LDA
#undef PG8_LDB
#undef PG8_MMA
#undef PG8_WAIT_V
#undef PG8_WAIT_L
#undef PG8_BAR
#undef PG8_SCHED
}
}

#ifndef PROBE_MASK
#define PROBE_MASK 0
#endif
#ifndef PROBE_N
#define PROBE_N 1
#endif
constexpr int NWAVES = 8, NTHR = 512;
constexpr int TOK = 16384, SEQ = 4096, DM = 1024, FF = 2816, MODLD = 9216;
constexpr float EPS = 1e-6f;
constexpr size_t MiB = 1u << 20;
constexpr size_t WS_BAR = 0;
constexpr size_t WS_SSQ = 64 * 1024;
constexpr size_t CTL_ZERO_BYTES = 512 * 1024;
constexpr size_t WS_MOD = 1 * MiB;
constexpr size_t WS_BIAS = WS_MOD + 512 * 1024;
constexpr int BIAS_IN0 = 4 * 4 * 5632, BIAS_IN1 = BIAS_IN0 + 4 * 2560;
constexpr size_t WS_WGU = 2 * MiB;
constexpr size_t WS_WD = 46 * MiB;
constexpr size_t WS_WHYIN = 68 * MiB;
constexpr size_t WS_WHYOUT = 73 * MiB;
constexpr size_t WS_WSCIN = 75 * MiB;
constexpr size_t WS_WSCOUT = 81 * MiB;
constexpr size_t WS_H = 83 * MiB;
constexpr size_t WS_R1 = 115 * MiB;
constexpr size_t WS_VT = WS_R1 + 64 * MiB;
constexpr size_t WS_HB = 211 * MiB;
constexpr size_t WS_XB = 243 * MiB;
constexpr size_t WS_END = 275 * MiB;
constexpr int LDS_BYTES = 131072 + 1024;

#define GAS __attribute__((address_space(1)))
#define LAS __attribute__((address_space(3)))
typedef unsigned short bf16;
typedef unsigned v4u __attribute__((ext_vector_type(4)));
typedef unsigned v2u __attribute__((ext_vector_type(2)));
typedef float f32x4 __attribute__((ext_vector_type(4)));
typedef float f32x16 __attribute__((ext_vector_type(16)));
typedef short bf16x8 __attribute__((ext_vector_type(8)));
#define LDS_WAIT() asm volatile("s_waitcnt lgkmcnt(0)" ::: "memory")

__device__ __forceinline__ unsigned pk2(float lo, float hi) { return pg8::cvt_pk_bf16(lo, hi); }
__device__ __forceinline__ float bf2f(unsigned short v) { return __uint_as_float((unsigned)v << 16); }
__device__ __forceinline__ float bflo(unsigned w) { return __uint_as_float(w << 16); }
__device__ __forceinline__ float bfhi(unsigned w) { return __uint_as_float(w & 0xffff0000u); }
__device__ __forceinline__ float wave_sum(float v) {
#pragma unroll
    for (int o = 1; o < 64; o <<= 1) v += __shfl_xor(v, o);
    return v;
}

#define XB_TMO      128
#define XB_XCNT(j)  (256  + 64 * (j))
#define XB_XSUB(j)  (1280 + 64 * (j))
#define XB_XGEN(j)  (2304 + 64 * (j))
#define XB_TOP      3328
#define XB_TOPGEN   3392
#define XCD_BAR_WORDS 3456
#define XB_SPIN_CAP (1u << 18)

__device__ __forceinline__ unsigned xb_ld(unsigned* p)              { return __hip_atomic_load(p, __ATOMIC_RELAXED, __HIP_MEMORY_SCOPE_AGENT); }
__device__ __forceinline__ unsigned xb_add(unsigned* p, unsigned v) { return __hip_atomic_fetch_add(p, v, __ATOMIC_RELAXED, __HIP_MEMORY_SCOPE_AGENT); }
__device__ __forceinline__ unsigned xb_xcc_id() { return (unsigned)__builtin_amdgcn_s_getreg((3 << 11) | 20) & 0xFu; }
#define XB_SPIN(cond, bar) do { unsigned _sp = 0; while (cond) { __builtin_amdgcn_s_sleep(1); \
    if ((++_sp & 255u) == 0u) { if (xb_ld(&(bar)[XB_TMO])) break; if (_sp > XB_SPIN_CAP) { atomicAdd(&(bar)[XB_TMO], 1u); break; } } } } while (0)

struct XcdBarrier {
    unsigned* bar; unsigned x;
    volatile LAS unsigned* st;
};

__device__ __forceinline__ XcdBarrier xcd_barrier_post(unsigned* bar, volatile LAS unsigned* st) {
    XcdBarrier b; b.bar = bar; b.x = xb_xcc_id(); b.st = st;
    if (threadIdx.x == 0) (void)xb_add(&bar[XB_XCNT(b.x)], 1u);
    return b;
}
__device__ __forceinline__ void xcd_barrier_complete(unsigned* bar, unsigned x, unsigned& nloc, unsigned& nx) {
    const unsigned G = gridDim.x * gridDim.y * gridDim.z;
    unsigned sum, cnt, mine, sp = 0u;
    for (;;) {
        sum = 0u; cnt = 0u; mine = 0u;
#pragma unroll
        for (unsigned j = 0; j < 16; ++j) { const unsigned c = xb_ld(&bar[XB_XCNT(j)]); sum += c; cnt += (c > 0u) ? 1u : 0u; mine = (j == x) ? c : mine; }
        if (sum == G) break;
        __builtin_amdgcn_s_sleep(1);
        if ((++sp & 255u) == 0u) { if (xb_ld(&bar[XB_TMO])) break; if (sp > XB_SPIN_CAP) { atomicAdd(&bar[XB_TMO], 1u); break; } }
    }
    nloc = mine > 0u ? mine : 1u; nx = cnt > 0u ? cnt : 1u;
}

__device__ __forceinline__ void xcd_barrier(const XcdBarrier& b) {
    asm volatile("s_waitcnt vmcnt(0)" ::: "memory");
    __syncthreads();
    if (threadIdx.x == 0) {
        unsigned* bar = b.bar;
        __builtin_amdgcn_s_waitcnt(0);
        unsigned nloc = b.st[0], nx = b.st[1];
        if (nloc == 0u) { xcd_barrier_complete(bar, b.x, nloc, nx); b.st[0] = nloc; b.st[1] = nx; }
        const unsigned old = xb_add(&bar[XB_XSUB(b.x)], 1u);
        const unsigned gen = old / nloc;
        if (old + 1u == (gen + 1u) * nloc) {
            __builtin_amdgcn_fence(__ATOMIC_RELEASE, "agent");
            asm volatile("s_waitcnt vmcnt(0)" ::: "memory");
            const unsigned og = xb_add(&bar[XB_TOP], 1u);
            const unsigned tg = og / nx;
            if (og + 1u == (tg + 1u) * nx) xb_add(&bar[XB_TOPGEN], 1u);
            else XB_SPIN(xb_ld(&bar[XB_TOPGEN]) == tg, bar);
            __builtin_amdgcn_fence(__ATOMIC_ACQUIRE, "agent");
            xb_add(&bar[XB_XGEN(b.x)], 1u);
            asm volatile("s_waitcnt vmcnt(0)" ::: "memory");
        } else {
            XB_SPIN(xb_ld(&bar[XB_XGEN(b.x)]) == gen, bar);
            __builtin_amdgcn_fence(__ATOMIC_ACQUIRE, "agent");
            asm volatile("s_waitcnt vmcnt(0)" ::: "memory");
        }
    }
    __syncthreads();
}

struct Args { const float* in[17]; float* out; unsigned char* ws; int lo, hi; };

struct TrItem { const float* src; bf16* dst; int N, K; };
__device__ __forceinline__ TrItem tr_make(const float* W, int K, int N, bf16* WT, int kind, int item) {
    const int nblk = N / 32, kb = item / nblk, nb = item % nblk, k0 = 64 * kb, n0 = 32 * nb;
    int orow0 = n0; if (kind == 1) orow0 = 256 * (n0 >> 7) + (n0 & 127); else if (kind == 2) orow0 = 256 * (n0 >> 7) + 128 + (n0 & 127);
    TrItem t; t.src = W + (size_t)k0 * N + n0; t.dst = WT + (size_t)orow0 * K + k0; t.N = N; t.K = K; return t;
}
__device__ __forceinline__ int mat_items(int id) { return id < 0 ? 0 : (id < 4 ? 2816 : (id < 8 ? 1408 : (id == 8 ? 1280 : (id == 10 ? 1536 : 512)))); }
__device__ __forceinline__ TrItem tr_decode_mat(const Args& A, unsigned char* ws, int id, int r) {
    if (id < 4) { if (r < 1408) return tr_make(A.in[5] + (size_t)id * DM * FF, DM, FF, (bf16*)(ws + WS_WGU) + (size_t)id * 5632 * 1024, 1, r);
                  return tr_make(A.in[6] + (size_t)id * DM * FF, DM, FF, (bf16*)(ws + WS_WGU) + (size_t)id * 5632 * 1024, 2, r - 1408); }
    if (id < 8) return tr_make(A.in[7] + (size_t)(id - 4) * FF * DM, FF, DM, (bf16*)(ws + WS_WD) + (size_t)(id - 4) * 1024 * FF, 0, r);
    if (id == 8) return tr_make(A.in[8], DM, 2560, (bf16*)(ws + WS_WHYIN), 0, r);
    if (id == 9) return tr_make(A.in[9], DM, DM, (bf16*)(ws + WS_WHYOUT), 0, r);
    if (id == 10) return tr_make(A.in[13], DM, 3072, (bf16*)(ws + WS_WSCIN), 0, r);
    return tr_make(A.in[15], DM, DM, (bf16*)(ws + WS_WSCOUT), 0, r);
}
__device__ __forceinline__ void slot_mats(int sel, int& m0, int& m1, int& m2) {
    m0 = (sel == 0) ? 0 : (sel == 1) ? 4 : (sel == 2) ? 5 : (sel == 3) ? 3 : 6;
    m1 = (sel == 0) ? 8 : (sel == 1) ? 1 : (sel == 2) ? 2 : (sel == 3) ? 10 : 7;
    m2 = (sel == 1) ? 9 : (sel == 4) ? 11 : -1;
}
__device__ __forceinline__ TrItem tr_decode(const Args& A, unsigned char* ws, int sel, int it) {
    int m0, m1, m2; slot_mats(sel, m0, m1, m2);
    const int n0 = mat_items(m0), n1 = mat_items(m1);
    if (it < n0) return tr_decode_mat(A, ws, m0, it);
    if (it < n0 + n1) return tr_decode_mat(A, ws, m1, it - n0);
    return tr_decode_mat(A, ws, m2, it - n0 - n1);
}
__device__ __forceinline__ void convert_items(const Args& A, unsigned char* ws, LAS float* scr, int sel, int gw, int NGW, int lane) {
    int sm0, sm1, sm2; slot_mats(sel, sm0, sm1, sm2);
    const int nitems = mat_items(sm0) + mat_items(sm1) + mat_items(sm2);
    int it = gw;
    if (it >= nitems) return;
    const int l5 = lane >> 5, l31 = lane & 31, c = lane & 7, nj = lane >> 3;
    TrItem cur = tr_decode(A, ws, sel, it);
    float tv[32];
#pragma unroll
    for (int i = 0; i < 32; ++i) tv[i] = __builtin_nontemporal_load(cur.src + (size_t)(2 * i + l5) * cur.N + l31);
    for (;;) {
#pragma unroll
        for (int i = 0; i < 32; ++i) scr[(2 * i + l5) * 33 + l31] = tv[i];
        const int itn = it + NGW; const bool more = itn < nitems;
        const TrItem nxt = tr_decode(A, ws, sel, more ? itn : it);
#pragma unroll
        for (int i = 0; i < 32; ++i) tv[i] = __builtin_nontemporal_load(nxt.src + (size_t)(2 * i + l5) * nxt.N + l31);
        LDS_WAIT(); asm volatile("" ::: "memory");
#pragma unroll
        for (int j = 0; j < 4; ++j) { const int n = nj + 8 * j; const LAS float* sp = scr + (8 * c) * 33 + n;
            v4u o; o.x = pk2(sp[0 * 33], sp[1 * 33]); o.y = pk2(sp[2 * 33], sp[3 * 33]); o.z = pk2(sp[4 * 33], sp[5 * 33]); o.w = pk2(sp[6 * 33], sp[7 * 33]);
            *(v4u*)(cur.dst + (size_t)n * cur.K + 8 * c) = o; }
        LDS_WAIT(); asm volatile("" ::: "memory");
        if (!more) break;
        cur = nxt; it = itn;
    }
}
__device__ __forceinline__ void phase_prologue(const Args& A, LAS unsigned char* lds, int G) {
    int tid_ = threadIdx.x; asm volatile("" : "+v"(tid_)); const int tid = tid_, lane = tid & 63, wid = tid >> 6;
    unsigned char* ws = A.ws;
    {
        LAS float* cs = (LAS float*)lds;
        LAS float* part = (LAS float*)(lds + 16384);
        const float* cin = A.in[1];
        for (int i = tid; i < 4096; i += NTHR) { const float c = cin[i]; cs[i] = c / (1.0f + __expf(-c)); }
        __syncthreads();
        const float* mod_w = A.in[2]; const float* mod_b = A.in[3]; float* MOD = (float*)(ws + WS_MOD);
        const int col = lane & 31, kg = wid * 2 + (lane >> 5);
        for (int unit = blockIdx.x; unit < 576; unit += G) {
            const int L = unit / 288, n0 = (unit % 288) * 32;
            const float* W = mod_w + (size_t)L * 1024 * MODLD + (size_t)(64 * kg) * MODLD + n0 + col;
            float a0 = 0.f, a1 = 0.f, a2 = 0.f, a3 = 0.f;
#pragma unroll 16
            for (int k = 0; k < 64; ++k) { const float w = __builtin_nontemporal_load(W + (size_t)k * MODLD); const int kk = 64 * kg + k;
                a0 += cs[kk] * w; a1 += cs[1024 + kk] * w; a2 += cs[2048 + kk] * w; a3 += cs[3072 + kk] * w; }
            part[(kg * 4 + 0) * 32 + col] = a0; part[(kg * 4 + 1) * 32 + col] = a1; part[(kg * 4 + 2) * 32 + col] = a2; part[(kg * 4 + 3) * 32 + col] = a3;
            __syncthreads();
            if (tid < 128) { const int b = tid >> 5, c = tid & 31; float s = mod_b[L * MODLD + n0 + c];
#pragma unroll
                for (int g = 0; g < 16; ++g) s += part[(g * 4 + b) * 32 + c];
                const int seg = (n0 + c) >> 10; if (seg == 2 || seg == 8) s *= 0.5f;
                MOD[(size_t)(L * 4 + b) * MODLD + n0 + c] = s; }
            __syncthreads();
        }
    }
    convert_items(A, ws, (LAS float*)(lds + wid * 16384), 0, blockIdx.x * NWAVES + wid, G * NWAVES, lane);
}

__device__ __forceinline__ void phase_norm0(const float* x, const float* g, const float* scale, bf16* XS, bf16* XB, float* ssq, int G) {
    int tid_ = threadIdx.x; asm volatile("" : "+v"(tid_)); const int tid = tid_, lane = tid & 63, wid = tid >> 6;
    const int gw = blockIdx.x * NWAVES + wid, NGW = G * NWAVES;
    f32x4 gv[4];
#pragma unroll
    for (int j = 0; j < 4; ++j) gv[j] = ((const f32x4*)g)[64 * j + lane];
    const bool aff = (G == 256);
    const int mstep = aff ? 256 : NGW; int m = aff ? 2048 * ((int)blockIdx.x & 7) + ((int)blockIdx.x >> 3) * NWAVES + wid : gw;
    int left = aff ? 8 : (gw < TOK ? (TOK - gw + NGW - 1) / NGW : 0);
    if (left == 0) return;
    f32x4 v[4];
#pragma unroll
    for (int j = 0; j < 4; ++j) v[j] = __builtin_nontemporal_load((const f32x4*)(x + (size_t)m * DM) + 64 * j + lane);
    for (;;) {
        const int mn = m + mstep; const bool more = left > 1; const int ml = more ? mn : m; --left;
        f32x4 nv[4];
#pragma unroll
        for (int j = 0; j < 4; ++j) nv[j] = __builtin_nontemporal_load((const f32x4*)(x + (size_t)ml * DM) + 64 * j + lane);
        const int b = m >> 12; float s = 0.f;
#pragma unroll
        for (int j = 0; j < 4; ++j) s += (v[j].x * v[j].x + v[j].y * v[j].y) + (v[j].z * v[j].z + v[j].w * v[j].w);
        s = wave_sum(s);
        if (lane == 0) ssq[m] = s;
        unsigned long long* o8 = (unsigned long long*)(XS + (size_t)m * DM) + lane; unsigned long long* x8 = (unsigned long long*)(XB + (size_t)m * DM) + lane;
#pragma unroll
        for (int j = 0; j < 4; ++j) {
            const f32x4 sc = ((const f32x4*)(scale + (size_t)b * MODLD))[64 * j + lane];
            const f32x4 y = v[j] * gv[j] * (sc + 1.0f);
            o8[64 * j] = (unsigned long long)pk2(y.x, y.y) | ((unsigned long long)pk2(y.z, y.w) << 32);
            x8[64 * j] = (unsigned long long)pk2(v[j].x, v[j].y) | ((unsigned long long)pk2(v[j].z, v[j].w) << 32);
        }
        if (!more) break;
#pragma unroll
        for (int j = 0; j < 4; ++j) v[j] = nv[j];
        m = mn;
    }
}
__device__ __forceinline__ void bias_rows(const bf16* Wt, int nrows, const float* shift, float* out, int pitch, int gw, int NGW, int lane) {
    f32x4 sh[4][4];
#pragma unroll
    for (int b = 0; b < 4; ++b)
#pragma unroll
        for (int q = 0; q < 4; ++q) sh[b][q] = *(const f32x4*)(shift + (size_t)b * MODLD + 16 * lane + 4 * q);
    for (int n = gw; n < nrows; n += 2 * NGW) {
        const int n2 = n + NGW; const bool has2 = n2 < nrows; const int n2c = has2 ? n2 : n;
        const v4u w0 = *(const v4u*)(Wt + (size_t)n * DM + 16 * lane), w1 = *(const v4u*)(Wt + (size_t)n * DM + 16 * lane + 8);
        const v4u x0 = *(const v4u*)(Wt + (size_t)n2c * DM + 16 * lane), x1 = *(const v4u*)(Wt + (size_t)n2c * DM + 16 * lane + 8);
        const f32x4 f0 = {bflo(w0.x), bfhi(w0.x), bflo(w0.y), bfhi(w0.y)}, f1 = {bflo(w0.z), bfhi(w0.z), bflo(w0.w), bfhi(w0.w)};
        const f32x4 f2 = {bflo(w1.x), bfhi(w1.x), bflo(w1.y), bfhi(w1.y)}, f3 = {bflo(w1.z), bfhi(w1.z), bflo(w1.w), bfhi(w1.w)};
        const f32x4 g0 = {bflo(x0.x), bfhi(x0.x), bflo(x0.y), bfhi(x0.y)}, g1 = {bflo(x0.z), bfhi(x0.z), bflo(x0.w), bfhi(x0.w)};
        const f32x4 g2 = {bflo(x1.x), bfhi(x1.x), bflo(x1.y), bfhi(x1.y)}, g3 = {bflo(x1.z), bfhi(x1.z), bflo(x1.w), bfhi(x1.w)};
        float acc[4], acd[4];
#pragma unroll
        for (int b = 0; b < 4; ++b) { const f32x4 t = sh[b][0] * f0 + sh[b][1] * f1 + sh[b][2] * f2 + sh[b][3] * f3; acc[b] = wave_sum((t.x + t.y) + (t.z + t.w));
            const f32x4 u = sh[b][0] * g0 + sh[b][1] * g1 + sh[b][2] * g2 + sh[b][3] * g3; acd[b] = wave_sum((u.x + u.y) + (u.z + u.w)); }
        if (lane == 0) { out[n] = acc[0]; out[pitch + n] = acc[1]; out[2 * pitch + n] = acc[2]; out[3 * pitch + n] = acc[3];
            if (has2) { out[n2] = acd[0]; out[pitch + n2] = acd[1]; out[2 * pitch + n2] = acd[2]; out[3 * pitch + n2] = acd[3]; } }
    }
}
__device__ __forceinline__ void bias_sets(unsigned char* ws, int sel, int gw, int NGW, int lane) {
    const float* MOD = (const float*)(ws + WS_MOD); float* BIAS = (float*)(ws + WS_BIAS);
    const int f = sel;
    bias_rows((const bf16*)(ws + WS_WGU) + (size_t)f * 5632 * 1024, 5632, MOD + (size_t)(f >> 1) * 4 * MODLD + ((f & 1) ? 6 * DM : 0), BIAS + (size_t)f * 4 * 5632, 5632, gw, NGW, lane);
    if (sel == 0) bias_rows((const bf16*)(ws + WS_WHYIN), 2560, MOD + 3 * DM, BIAS + BIAS_IN0, 2560, gw, NGW, lane);
    if (sel == 3) bias_rows((const bf16*)(ws + WS_WSCIN), 3072, MOD + (size_t)4 * MODLD + 3 * DM, BIAS + BIAS_IN1, 3072, gw, NGW, lane);
}
__device__ __forceinline__ void filler(const Args& A, unsigned char* ws, LAS unsigned char* lds, int p, int G) {
    const bool half = (G == 256);
    if (half && (int)blockIdx.x < 128) return;
    int tid_ = threadIdx.x; asm volatile("" : "+v"(tid_)); const int tid = tid_, lane = tid & 63, wid = tid >> 6;
    const int gw = ((int)blockIdx.x - (half ? 128 : 0)) * NWAVES + wid, NGW = (half ? 128 : G) * NWAVES;
    LAS float* scr = (LAS float*)(lds + wid * 16384);
    if (p == 2) convert_items(A, ws, scr, 1, gw, NGW, lane);
    else if (p == 4) { convert_items(A, ws, scr, 2, gw, NGW, lane); bias_sets(ws, 1, gw, NGW, lane); }
    else if (p == 7) { convert_items(A, ws, scr, 3, gw, NGW, lane); bias_sets(ws, 2, gw, NGW, lane); }
    else if (p == 9) { convert_items(A, ws, scr, 4, gw, NGW, lane); bias_sets(ws, 3, gw, NGW, lane); }
}
__device__ __forceinline__ void phase_bias(unsigned char* ws, int G) {
    int tid_ = threadIdx.x; asm volatile("" : "+v"(tid_)); const int tid = tid_, lane = tid & 63, wid = tid >> 6;
    bias_sets(ws, 0, blockIdx.x * NWAVES + wid, G * NWAVES, lane);
}
__device__ __forceinline__ void phase_final_norm(const bf16* xb, float* out, const float* g, const float* ssq, int G) {
    int tid_ = threadIdx.x; asm volatile("" : "+v"(tid_)); const int tid = tid_, lane = tid & 63, wid = tid >> 6;
    const int gw = blockIdx.x * NWAVES + wid, NGW = G * NWAVES;
    f32x4 gv[4];
#pragma unroll
    for (int j = 0; j < 4; ++j) gv[j] = ((const f32x4*)g)[64 * j + lane];
    const bool aff = (G == 256);
    const int mstep = aff ? 256 : NGW; int m = aff ? 2048 * ((int)blockIdx.x & 7) + ((int)blockIdx.x >> 3) * NWAVES + wid : gw;
    int left = aff ? 8 : (gw < TOK ? (TOK - gw + NGW - 1) / NGW : 0);
    if (left == 0) return;
    v2u v[4]; float sq = ssq[m];
#pragma unroll
    for (int j = 0; j < 4; ++j) v[j] = ((const v2u*)(xb + (size_t)m * DM))[64 * j + lane];
    for (;;) {
        const int mn = m + mstep; const bool more = left > 1; const int ml = more ? mn : m; --left;
        v2u nv[4]; const float nsq = ssq[ml];
#pragma unroll
        for (int j = 0; j < 4; ++j) nv[j] = ((const v2u*)(xb + (size_t)ml * DM))[64 * j + lane];
        const float rstd = __builtin_amdgcn_rsqf(sq * (1.0f / DM) + EPS);
        f32x4* xr = (f32x4*)(out + (size_t)m * DM) + lane;
#pragma unroll
        for (int j = 0; j < 4; ++j) { const f32x4 xv = {bflo(v[j].x), bfhi(v[j].x), bflo(v[j].y), bfhi(v[j].y)}; xr[64 * j] = xv * rstd * gv[j]; }
        if (!more) break;
#pragma unroll
        for (int j = 0; j < 4; ++j) v[j] = nv[j];
        sq = nsq; m = mn;
    }
}

__device__ __forceinline__ int sgu_unit_id(bool aff, int bx, int G, int it) {
    const int xx = bx & 7, jj = bx >> 3;
    return aff ? (((xx >> 1) << 8) | ((((xx & 1) * 16 + 4 * (jj >> 3) + it)) << 3) | (jj & 7)) : bx + it * G;
}
__device__ __forceinline__ void sgu_phase(const bf16* P1, bf16* Y, const float* vng, const float* w_s, const float* b_s, LAS unsigned char* lds, int G) {
    int tid_ = threadIdx.x; asm volatile("" : "+v"(tid_)); const int tid = tid_, lane = tid & 63, wid = __builtin_amdgcn_readfirstlane(tid >> 6);
    constexpr int VS = 272, VBUF = 64 * VS, WSL = 2 * VBUF;
    const int sl = tid >> 2, dq = tid & 3;
    const int tb = wid >> 1, db = wid & 1, r = lane & 31, hh = lane >> 5, t = 32 * tb + r, d = 32 * db + r, nkc = 2 * (tb + 1);
    const bool aff = (G == 256); const int bx = blockIdx.x; const int nit = aff ? 4 : (bx < 1024 ? (1024 - bx + G - 1) / G : 0);
    if (nit == 0) return;
    int unit = sgu_unit_id(aff, bx, G, 0);
    v4u r0, r1; v2u uq[4]; float bt;
    { const int hA = unit & 7, chunk = (unit >> 3) & 31, b = unit >> 8; const size_t row0 = (size_t)b * SEQ + chunk * 128;
      const bf16* vp = P1 + (row0 + sl) * 2048 + 512 + hA * 64 + dq * 16; r0 = *(const v4u*)vp; r1 = *(const v4u*)(vp + 8);
#pragma unroll
      for (int g = 0; g < 4; ++g) uq[g] = *(const v2u*)(P1 + (row0 + t) * 2048 + hA * 64 + 32 * db + 8 * g + 4 * hh);
      bt = b_s[hA * 128 + t]; }
    int cur = 0, curh = -1;
    for (int it = 0; it < nit; ++it) {
        unit = sgu_unit_id(aff, bx, G, it);
        const int hA = unit & 7, chunk = (unit >> 3) & 31, b = unit >> 8;
        const size_t row0 = (size_t)b * SEQ + chunk * 128;
        LAS unsigned char* vbuf = lds + cur * VBUF;
        if (hA != curh) {
            if (curh >= 0) __syncthreads();
            const int wr_ = tid >> 2, wq_ = tid & 3; const float* wp = w_s + ((size_t)hA * 128 + wr_) * 128 + 32 * wq_;
            f32x4 wl[8];
#pragma unroll
            for (int q = 0; q < 8; ++q) wl[q] = *(const f32x4*)(wp + 4 * q);
#pragma unroll
            for (int q = 0; q < 4; ++q) { const int s0_ = 32 * wq_ + 8 * q; float wf[8] = {wl[2 * q].x, wl[2 * q].y, wl[2 * q].z, wl[2 * q].w, wl[2 * q + 1].x, wl[2 * q + 1].y, wl[2 * q + 1].z, wl[2 * q + 1].w};
#pragma unroll
                for (int j = 0; j < 8; ++j) wf[j] = (s0_ + j <= wr_) ? wf[j] : 0.f;
                v4u au; au.x = pk2(wf[0], wf[1]); au.y = pk2(wf[2], wf[3]); au.z = pk2(wf[4], wf[5]); au.w = pk2(wf[6], wf[7]);
                *(LAS v4u*)(lds + WSL + wr_ * VS + (s0_ * 2)) = au; }
            curh = hA;
        }
        {
            float f[16];
            f[0] = bflo(r0.x); f[1] = bfhi(r0.x); f[2] = bflo(r0.y); f[3] = bfhi(r0.y); f[4] = bflo(r0.z); f[5] = bfhi(r0.z); f[6] = bflo(r0.w); f[7] = bfhi(r0.w);
            f[8] = bflo(r1.x); f[9] = bfhi(r1.x); f[10] = bflo(r1.y); f[11] = bfhi(r1.y); f[12] = bflo(r1.z); f[13] = bfhi(r1.z); f[14] = bflo(r1.w); f[15] = bfhi(r1.w);
            float ss = 0.f;
#pragma unroll
            for (int i = 0; i < 16; ++i) ss += f[i] * f[i];
            ss += __shfl_xor(ss, 1); ss += __shfl_xor(ss, 2);
            const float rstd = __builtin_amdgcn_rsqf(ss * (1.0f / 64.0f) + EPS);
#pragma unroll
            for (int i = 0; i < 16; ++i) { const int dd = dq * 16 + i; const float y = f[i] * rstd * vng[hA * 64 + dd];
                *(LAS unsigned short*)(vbuf + dd * VS + sl * 2) = (unsigned short)(pk2(y, 0.f) & 0xffffu); }
        }
        const int un = sgu_unit_id(aff, bx, G, (it + 1 < nit) ? it + 1 : it);
        const int hA2 = un & 7, chunk2 = (un >> 3) & 31, b2 = un >> 8; const size_t row2 = (size_t)b2 * SEQ + chunk2 * 128;
        { const bf16* vp = P1 + (row2 + sl) * 2048 + 512 + hA2 * 64 + dq * 16; r0 = *(const v4u*)vp; r1 = *(const v4u*)(vp + 8); }
        __syncthreads();
        f32x16 acc;
#pragma unroll
        for (int i = 0; i < 16; ++i) acc[i] = 0.f;
        const LAS unsigned char* vb = vbuf + d * VS + 16 * hh; const LAS unsigned char* wt = lds + WSL + t * VS + 16 * hh;
#pragma unroll
        for (int kc = 0; kc < 8; ++kc) if (kc < nkc) {
            const bf16x8 wf = *(const LAS bf16x8*)(wt + 32 * kc);
            const bf16x8 vf = *(const LAS bf16x8*)(vb + 32 * kc);
            acc = __builtin_amdgcn_mfma_f32_32x32x16_bf16(vf, wf, acc, 0, 0, 0);
        }
        v2u o[4];
#pragma unroll
        for (int g = 0; g < 4; ++g) { const float y0 = bflo(uq[g].x) * (acc[4 * g] + bt), y1 = bfhi(uq[g].x) * (acc[4 * g + 1] + bt), y2 = bflo(uq[g].y) * (acc[4 * g + 2] + bt), y3 = bfhi(uq[g].y) * (acc[4 * g + 3] + bt);
            o[g].x = pk2(y0, y1); o[g].y = pk2(y2, y3); }
#pragma unroll
        for (int g = 0; g < 4; ++g) uq[g] = *(const v2u*)(P1 + (row2 + t) * 2048 + hA2 * 64 + 32 * db + 8 * g + 4 * hh);
        bt = b_s[hA2 * 128 + t];
#pragma unroll
        for (int g = 0; g < 4; ++g) *(v2u*)(Y + (row0 + t) * 1024 + hA * 64 + 32 * db + 8 * g + 4 * hh) = o[g];
        cur ^= 1;
    }
}

typedef float f32x2 __attribute__((ext_vector_type(2)));
struct SbK { float c0, c1, cm; };
template <int ODD> __device__ __forceinline__ float mul_np(float a, float b, const SbK& k) { return ODD ? __builtin_fmaf(a, b, k.c0) : a * b; }
template <int ODD> __device__ __forceinline__ float inc_np(float e, const SbK& k) { return ODD ? __builtin_fmaf(e, k.c1, 1.0f) : 1.0f + e; }
template <int ODD> __device__ __forceinline__ float omb_np(float be, const SbK& k) { return ODD ? __builtin_fmaf(be, k.cm, 1.0f) : 1.0f - be; }
template <bool MASK> __device__ __forceinline__ void sb_block(const f32x16& sc, int kb0, int t, int hh, float& R, bf16x8& pb0, bf16x8& pb1, const SbK& k) {
    float be[16], om[16];
#pragma unroll
    for (int i = 0; i < 16; i += 2) {
        const float e0 = __builtin_amdgcn_exp2f(sc[i]), e1 = __builtin_amdgcn_exp2f(sc[i + 1]);
        be[i] = __builtin_amdgcn_rcpf(inc_np<0>(e0, k)); be[i + 1] = __builtin_amdgcn_rcpf(inc_np<1>(e1, k));
        om[i] = omb_np<0>(be[i], k); om[i + 1] = omb_np<1>(be[i + 1], k);
    }
    if (MASK) {
#pragma unroll
        for (int i = 0; i < 16; ++i) { const int key = kb0 + 16 * (i >> 3) + 8 * hh + (i & 7); const bool ok = key < t; be[i] = ok ? be[i] : 0.f; om[i] = ok ? om[i] : 1.0f; }
    }
    float ex[16];
    ex[7] = 1.0f; ex[15] = 1.0f;
    ex[6] = om[7]; ex[14] = om[15];
#pragma unroll
    for (int j = 5; j >= 0; --j) { ex[j] = mul_np<0>(ex[j + 1], om[j + 1], k); ex[8 + j] = mul_np<1>(ex[8 + j + 1], om[8 + j + 1], k); }
    const float T0 = mul_np<0>(ex[0], om[0], k), T1 = mul_np<1>(ex[8], om[8], k);
    const float Tp0 = __shfl_xor(T0, 32), Tp1 = __shfl_xor(T1, 32);
    const float P1t = T1 * Tp1, PR = P1t * R;
    const float A0 = (hh == 0 ? Tp0 : 1.0f) * PR, A1 = __builtin_fmaf(hh == 0 ? Tp1 : 1.0f, R, k.c0);
    R = (T0 * Tp0) * PR;
    float w[16];
    w[7] = mul_np<1>(be[7], A0, k); w[15] = mul_np<0>(be[15], A1, k);
#pragma unroll
    for (int j = 0; j < 7; ++j) {
        if (j & 1) { w[j] = mul_np<1>(mul_np<1>(be[j], ex[j], k), A0, k); w[8 + j] = mul_np<0>(mul_np<0>(be[8 + j], ex[8 + j], k), A1, k); }
        else       { w[j] = mul_np<0>(mul_np<0>(be[j], ex[j], k), A0, k); w[8 + j] = mul_np<1>(mul_np<1>(be[8 + j], ex[8 + j], k), A1, k); }
    }
    v4u pu0, pu1;
    pu0.x = pk2(w[0], w[1]); pu0.y = pk2(w[2], w[3]); pu0.z = pk2(w[4], w[5]); pu0.w = pk2(w[6], w[7]);
    pu1.x = pk2(w[8], w[9]); pu1.y = pk2(w[10], w[11]); pu1.z = pk2(w[12], w[13]); pu1.w = pk2(w[14], w[15]);
    pb0 = __builtin_bit_cast(bf16x8, pu0); pb1 = __builtin_bit_cast(bf16x8, pu1);
}
__device__ __forceinline__ void attn_tile(const LAS unsigned char* kbuf, const LAS unsigned char* vbuf, const bf16x8 (&bq)[4], int k0, int q0, int t, int n, int hh, int pin, f32x16& o0, f32x16& o1, float& R, const SbK& sk) {
    constexpr int RS = 144;
    if (k0 < q0 + 31) {
        const bool do1 = (k0 + 32 < q0 + 31);
        const LAS unsigned char* kp = kbuf + pin * RS + hh * 16;
        const LAS unsigned char* vp = vbuf + n * RS + hh * 16;
        const f32x16 z16 = {0.f, 0.f, 0.f, 0.f, 0.f, 0.f, 0.f, 0.f, 0.f, 0.f, 0.f, 0.f, 0.f, 0.f, 0.f, 0.f};
        bf16x8 pb0, pb1;
        if (k0 + 63 < q0) {
            f32x16 s0, s1;
            { const bf16x8 a1 = *(const LAS bf16x8*)(kp + 32 * RS), a0 = *(const LAS bf16x8*)(kp);
              s1 = __builtin_amdgcn_mfma_f32_32x32x16_bf16(a1, bq[0], z16, 0, 0, 0); s0 = __builtin_amdgcn_mfma_f32_32x32x16_bf16(a0, bq[0], z16, 0, 0, 0); }
#pragma unroll
            for (int c = 1; c < 4; ++c) { const bf16x8 a1 = *(const LAS bf16x8*)(kp + 32 * RS + c * 32), a0 = *(const LAS bf16x8*)(kp + c * 32);
                s1 = __builtin_amdgcn_mfma_f32_32x32x16_bf16(a1, bq[c], s1, 0, 0, 0); s0 = __builtin_amdgcn_mfma_f32_32x32x16_bf16(a0, bq[c], s0, 0, 0, 0); }
            sb_block<false>(s1, k0 + 32, t, hh, R, pb0, pb1, sk);
            { const bf16x8 a00 = *(const LAS bf16x8*)(vp + 64), a01 = *(const LAS bf16x8*)(vp + 32 * RS + 64), a10 = *(const LAS bf16x8*)(vp + 96), a11 = *(const LAS bf16x8*)(vp + 32 * RS + 96);
              o0 = __builtin_amdgcn_mfma_f32_32x32x16_bf16(a00, pb0, o0, 0, 0, 0); o1 = __builtin_amdgcn_mfma_f32_32x32x16_bf16(a01, pb0, o1, 0, 0, 0);
              o0 = __builtin_amdgcn_mfma_f32_32x32x16_bf16(a10, pb1, o0, 0, 0, 0); o1 = __builtin_amdgcn_mfma_f32_32x32x16_bf16(a11, pb1, o1, 0, 0, 0); }
            sb_block<false>(s0, k0, t, hh, R, pb0, pb1, sk);
            { const bf16x8 a00 = *(const LAS bf16x8*)(vp), a01 = *(const LAS bf16x8*)(vp + 32 * RS), a10 = *(const LAS bf16x8*)(vp + 32), a11 = *(const LAS bf16x8*)(vp + 32 * RS + 32);
              o0 = __builtin_amdgcn_mfma_f32_32x32x16_bf16(a00, pb0, o0, 0, 0, 0); o1 = __builtin_amdgcn_mfma_f32_32x32x16_bf16(a01, pb0, o1, 0, 0, 0);
              o0 = __builtin_amdgcn_mfma_f32_32x32x16_bf16(a10, pb1, o0, 0, 0, 0); o1 = __builtin_amdgcn_mfma_f32_32x32x16_bf16(a11, pb1, o1, 0, 0, 0); }
        } else {
            asm volatile("" ::: "memory");
            if (do1) {
                f32x16 s1 = __builtin_amdgcn_mfma_f32_32x32x16_bf16(*(const LAS bf16x8*)(kp + 32 * RS), bq[0], z16, 0, 0, 0);
#pragma unroll
                for (int c = 1; c < 4; ++c) s1 = __builtin_amdgcn_mfma_f32_32x32x16_bf16(*(const LAS bf16x8*)(kp + 32 * RS + c * 32), bq[c], s1, 0, 0, 0);
                sb_block<true>(s1, k0 + 32, t, hh, R, pb0, pb1, sk);
                const bf16x8 a00 = *(const LAS bf16x8*)(vp + 64), a01 = *(const LAS bf16x8*)(vp + 32 * RS + 64), a10 = *(const LAS bf16x8*)(vp + 96), a11 = *(const LAS bf16x8*)(vp + 32 * RS + 96);
                o0 = __builtin_amdgcn_mfma_f32_32x32x16_bf16(a00, pb0, o0, 0, 0, 0); o1 = __builtin_amdgcn_mfma_f32_32x32x16_bf16(a01, pb0, o1, 0, 0, 0);
                o0 = __builtin_amdgcn_mfma_f32_32x32x16_bf16(a10, pb1, o0, 0, 0, 0); o1 = __builtin_amdgcn_mfma_f32_32x32x16_bf16(a11, pb1, o1, 0, 0, 0);
            }
            {
                f32x16 s0 = __builtin_amdgcn_mfma_f32_32x32x16_bf16(*(const LAS bf16x8*)(kp), bq[0], z16, 0, 0, 0);
#pragma unroll
                for (int c = 1; c < 4; ++c) s0 = __builtin_amdgcn_mfma_f32_32x32x16_bf16(*(const LAS bf16x8*)(kp + c * 32), bq[c], s0, 0, 0, 0);
                sb_block<true>(s0, k0, t, hh, R, pb0, pb1, sk);
                const bf16x8 a00 = *(const LAS bf16x8*)(vp), a01 = *(const LAS bf16x8*)(vp + 32 * RS), a10 = *(const LAS bf16x8*)(vp + 32), a11 = *(const LAS bf16x8*)(vp + 32 * RS + 32);
                o0 = __builtin_amdgcn_mfma_f32_32x32x16_bf16(a00, pb0, o0, 0, 0, 0); o1 = __builtin_amdgcn_mfma_f32_32x32x16_bf16(a01, pb0, o1, 0, 0, 0);
                o0 = __builtin_amdgcn_mfma_f32_32x32x16_bf16(a10, pb1, o0, 0, 0, 0); o1 = __builtin_amdgcn_mfma_f32_32x32x16_bf16(a11, pb1, o1, 0, 0, 0);
            }
        }
    }
}
__device__ __forceinline__ void attn_unit(const bf16* P1, const bf16* Vt, bf16* Y, int b, int h, int qb, LAS unsigned char* lds) {
    int tid_ = threadIdx.x; asm volatile("" : "+v"(tid_)); const int tid = tid_, lane = tid & 63, wid = __builtin_amdgcn_readfirstlane(tid >> 6);
    const int n = lane & 31, hh = lane >> 5;
    const int Q0 = qb * 256, q0 = Q0 + wid * 32, t = q0 + n;
    const size_t rowbase = (size_t)b * SEQ;
    constexpr int RS = 144, KB_BYTES = 64 * RS, ABUF = 2 * KB_BYTES;
    bf16x8 bq[4];
    { const bf16* qp = P1 + (rowbase + t) * 2048 + 1024 + h * 64 + 8 * hh;
#pragma unroll
      for (int c = 0; c < 4; ++c) bq[c] = *(const bf16x8*)(qp + 16 * c); }
    f32x16 o0, o1;
#pragma unroll
    for (int i = 0; i < 16; ++i) { o0[i] = 0.f; o1[i] = 0.f; }
    float R = 1.0f;
    SbK sk; sk.c0 = 0.0f; sk.c1 = 1.0f; sk.cm = -1.0f; asm volatile("" : "+v"(sk.c0), "+v"(sk.c1), "+v"(sk.cm));
    const int ntiles = (Q0 + 256) / 64;
    const int srow = tid >> 3, sch = tid & 7;
    const bf16* kg = P1 + (rowbase + srow) * 2048 + 1536 + h * 64 + sch * 8;
    const bf16* vg = Vt + (size_t)(h * 64 + srow) * TOK + rowbase + sch * 8;
    const int soff = srow * RS + sch * 16;
    const int pin = (n & 0x13) | ((n & 8) >> 1) | ((n & 4) << 1);
#define KLOAD(kt_) (*(const v4u*)(kg + (size_t)(64 * (kt_)) * 2048))
#define VLOAD(kt_) (*(const v4u*)(vg + 64 * (kt_)))
    v4u kA = KLOAD(ntiles - 1), vA = VLOAD(ntiles - 1);
    v4u kB = KLOAD(ntiles - 2), vB = VLOAD(ntiles - 2);
    *(LAS v4u*)(lds + soff) = kA; *(LAS v4u*)(lds + KB_BYTES + soff) = vA;
    __syncthreads();
    LAS unsigned* flags = (LAS unsigned*)(lds + 2 * ABUF);
    bool alive = true;
    for (int kt = ntiles - 1; kt >= 0; kt -= 2) {
        { const int kp2 = kt >= 2 ? kt - 2 : 0; kA = KLOAD(kp2); vA = VLOAD(kp2); }
        if (alive) { attn_tile(lds, lds + KB_BYTES, bq, kt * 64, q0, t, n, hh, pin, o0, o1, R, sk); alive = __builtin_amdgcn_ballot_w64(R != 0.0f) != 0ull; }
        if (lane == 0) flags[wid] = alive ? 1u : 0u;
        *(LAS v4u*)(lds + ABUF + soff) = kB; *(LAS v4u*)(lds + ABUF + KB_BYTES + soff) = vB;
        __syncthreads();
        if (__builtin_amdgcn_ballot_w64(flags[lane & 7] != 0u) == 0ull) break;
        { const int kp3 = kt >= 3 ? kt - 3 : 0; kB = KLOAD(kp3); vB = VLOAD(kp3); }
        if (alive) { attn_tile(lds + ABUF, lds + ABUF + KB_BYTES, bq, (kt - 1) * 64, q0, t, n, hh, pin, o0, o1, R, sk); alive = __builtin_amdgcn_ballot_w64(R != 0.0f) != 0ull; }
        if (lane == 0) flags[8 + wid] = alive ? 1u : 0u;
        if (kt >= 2) { *(LAS v4u*)(lds + soff) = kA; *(LAS v4u*)(lds + KB_BYTES + soff) = vA; }
        __syncthreads();
        if (__builtin_amdgcn_ballot_w64(flags[8 + (lane & 7)] != 0u) == 0ull) break;
    }
    __syncthreads();
#undef KLOAD
#undef VLOAD
    bf16* yp = Y + (rowbase + t) * 1024 + 512 + h * 64 + 4 * hh;
#pragma unroll
    for (int g = 0; g < 4; ++g) {
        v2u w0; w0.x = pk2(o0[4 * g], o0[4 * g + 1]); w0.y = pk2(o0[4 * g + 2], o0[4 * g + 3]);
        v2u w1; w1.x = pk2(o1[4 * g], o1[4 * g + 1]); w1.y = pk2(o1[4 * g + 2], o1[4 * g + 3]);
        *(v2u*)(yp + 8 * g) = w0; *(v2u*)(yp + 32 + 8 * g) = w1;
    }
}

__device__ __forceinline__ void phase_mixer0(const Args& A, LAS unsigned char* lds, int G) {
    const bf16* P1 = (const bf16*)(A.ws + WS_R1); const bf16* Vt = (const bf16*)(A.ws + WS_VT); bf16* Y = (bf16*)(A.ws + WS_H);
    for (int p = blockIdx.x; p < 256; p += G) {
        const int x = p & 7, i = p >> 3, b = x >> 1, h = i >> 2, jq = i & 3, qb0 = 8 * (x & 1);
        attn_unit(P1, Vt, Y, b, h, qb0 + 7 - jq, lds);
        attn_unit(P1, Vt, Y, b, h, qb0 + jq, lds);
    }
    __syncthreads();
    sgu_phase(P1, Y, A.in[10], A.in[11], A.in[12], lds, G);
}

__device__ __forceinline__ void phase_conv(const Args& A, int G) {
    const bf16* PS = (const bf16*)(A.ws + WS_R1); bf16* Y = (bf16*)(A.ws + WS_H); const float* cw = A.in[14];
    int tid_ = threadIdx.x; asm volatile("" : "+v"(tid_)); const int tid = tid_, cgp = tid & 127, sub = tid >> 7, ch0 = cgp * 8;
    float w0[8], w1[8], w2[8];
#pragma unroll
    for (int i = 0; i < 8; ++i) { w0[i] = cw[ch0 + i]; w1[i] = cw[1024 + ch0 + i]; w2[i] = cw[2048 + ch0 + i]; }
    const bool aff = (G == 256); const int cbx = blockIdx.x; const int cnit = aff ? 2 : (cbx < TOK / 32 ? (TOK / 32 - cbx + G - 1) / G : 0);
    for (int cit = 0; cit < cnit; ++cit) { const int unit = aff ? 64 * (cbx & 7) + 2 * (cbx >> 3) + cit : cbx + cit * G;
        const int r0 = unit * 32 + sub * 8; const bool halo = (r0 & (SEQ - 1)) != 0;
        float pm2[8], pm1[8];
#pragma unroll
        for (int i = 0; i < 8; ++i) { pm2[i] = 0.f; pm1[i] = 0.f; }
        if (halo) {
            const v4u c2 = *(const v4u*)(PS + (size_t)(r0 - 2) * 3072 + 1024 + ch0), x2 = *(const v4u*)(PS + (size_t)(r0 - 2) * 3072 + 2048 + ch0);
            const v4u c1 = *(const v4u*)(PS + (size_t)(r0 - 1) * 3072 + 1024 + ch0), x1 = *(const v4u*)(PS + (size_t)(r0 - 1) * 3072 + 2048 + ch0);
            pm2[0] = bflo(c2.x) * bflo(x2.x); pm2[1] = bfhi(c2.x) * bfhi(x2.x); pm2[2] = bflo(c2.y) * bflo(x2.y); pm2[3] = bfhi(c2.y) * bfhi(x2.y);
            pm2[4] = bflo(c2.z) * bflo(x2.z); pm2[5] = bfhi(c2.z) * bfhi(x2.z); pm2[6] = bflo(c2.w) * bflo(x2.w); pm2[7] = bfhi(c2.w) * bfhi(x2.w);
            pm1[0] = bflo(c1.x) * bflo(x1.x); pm1[1] = bfhi(c1.x) * bfhi(x1.x); pm1[2] = bflo(c1.y) * bflo(x1.y); pm1[3] = bfhi(c1.y) * bfhi(x1.y);
            pm1[4] = bflo(c1.z) * bflo(x1.z); pm1[5] = bfhi(c1.z) * bfhi(x1.z); pm1[6] = bflo(c1.w) * bflo(x1.w); pm1[7] = bfhi(c1.w) * bfhi(x1.w);
        }
        v4u bgv[8], cgv8[8], xv8[8];
#pragma unroll
        for (int i = 0; i < 8; ++i) { const bf16* rp = PS + (size_t)(r0 + i) * 3072 + ch0; bgv[i] = *(const v4u*)rp; cgv8[i] = *(const v4u*)(rp + 1024); xv8[i] = *(const v4u*)(rp + 2048); }
#pragma unroll
        for (int i = 0; i < 8; ++i) {
            const v4u bg = bgv[i], cgv = cgv8[i], xv = xv8[i];
            float p[8], bgf[8], y[8];
            p[0] = bflo(cgv.x) * bflo(xv.x); p[1] = bfhi(cgv.x) * bfhi(xv.x); p[2] = bflo(cgv.y) * bflo(xv.y); p[3] = bfhi(cgv.y) * bfhi(xv.y);
            p[4] = bflo(cgv.z) * bflo(xv.z); p[5] = bfhi(cgv.z) * bfhi(xv.z); p[6] = bflo(cgv.w) * bflo(xv.w); p[7] = bfhi(cgv.w) * bfhi(xv.w);
            bgf[0] = bflo(bg.x); bgf[1] = bfhi(bg.x); bgf[2] = bflo(bg.y); bgf[3] = bfhi(bg.y); bgf[4] = bflo(bg.z); bgf[5] = bfhi(bg.z); bgf[6] = bflo(bg.w); bgf[7] = bfhi(bg.w);
#pragma unroll
            for (int c = 0; c < 8; ++c) { y[c] = bgf[c] * (w0[c] * pm2[c] + w1[c] * pm1[c] + w2[c] * p[c]); pm2[c] = pm1[c]; pm1[c] = p[c]; }
            v4u o; o.x = pk2(y[0], y[1]); o.y = pk2(y[2], y[3]); o.z = pk2(y[4], y[5]); o.w = pk2(y[6], y[7]);
            *(v4u*)(Y + (size_t)(r0 + i) * 1024 + ch0) = o;
        }
    }
}

constexpr int N_PHASES = 17;
__global__ void __launch_bounds__(NTHR, 2) mega_fwd(Args A) {
    extern __shared__ __attribute__((aligned(16))) unsigned char lds_raw[];
    LAS unsigned char* lds = (LAS unsigned char*)lds_raw;
    cg::grid_group grid = cg::this_grid();
    const int G = gridDim.x;
    volatile LAS unsigned* bst = (volatile LAS unsigned*)(lds + 131072);
    if (threadIdx.x < 2) bst[threadIdx.x] = 0u;
    __syncthreads();
    XcdBarrier xbar = xcd_barrier_post((unsigned*)(A.ws + WS_BAR), bst);
    if (A.hi > 1000) grid.sync();
    for (int p = A.lo; p < A.hi; ++p) {
      for (int rep = 0; rep <= (((PROBE_MASK >> p) & 1) ? PROBE_N : 0); ++rep) {
        if (rep) __syncthreads();
        size_t zoff = 0; asm volatile("" : "+s"(zoff));
        unsigned char* ws = A.ws + zoff;
        float* X = A.out + zoff;
        const float* MOD = (const float*)(ws + WS_MOD);
        float* SSQ = (float*)(ws + WS_SSQ);
        const float* BIAS = (const float*)(ws + WS_BIAS);
        bf16* HA = (bf16*)(ws + WS_H); bf16* HB = (bf16*)(ws + WS_HB); bf16* XB = (bf16*)(ws + WS_XB);
        if (p == 0) phase_prologue(A, lds, G);
        else if (p == 1) { phase_norm0(A.in[0], A.in[4], MOD + DM, HA, XB, SSQ, G); phase_bias(ws, G); }
        else if (p == 16) phase_final_norm(XB, X, A.in[16], SSQ + 6 * TOK, G);
        else {
            const int q = p - 2, L = q / 7, r = q % 7, s = (r < 2) ? 0 : (r < 5 ? 1 : 2), j = L * 3 + s;
            const float* modL = MOD + (size_t)L * 4 * MODLD;
            const float* ssqj = SSQ + (size_t)j * TOK;
            if (r == 0 || r == 5) {
                const int f = L * 2 + (s >> 1);
                pg8::Gemm g{r == 5 ? HB : HA, (const bf16*)(ws + WS_WGU) + (size_t)f * 5632 * 1024, TOK, 5632, DM}; pg8::StaticOrder S; S.init(TOK, 5632, G, (int)blockIdx.x);
                pg8::EpiSwiGLU E{(bf16*)(ws + WS_R1), FF, ssqj, BIAS + (size_t)f * 4 * 5632};
                pg8::gemm_phase<pg8::EpiSwiGLU, pg8::StaticOrder, true, true>(lds, g, S, E);
                if (!rep) filler(A, ws, lds, p, G);
            } else if (r == 2) {
                {
                    const int N = (L == 0) ? 2048 : 3072;
                    const pg8::Gemm g{HA, (const bf16*)(ws + (L == 0 ? WS_WHYIN : WS_WSCIN)), TOK, N, DM};
                    const pg8::EpiBf16G<false> E{(bf16*)(ws + WS_R1), N, (L == 0) ? 4 : 0, ssqj, BIAS + (L == 0 ? BIAS_IN0 : BIAS_IN1), (L == 0) ? 2560 : 3072};
                    pg8::StaticOrder S; S.init(g.M, g.N, G, (int)blockIdx.x);
                    pg8::gemm_phase<pg8::EpiBf16G<false>, pg8::StaticOrder, true, true>(lds, g, S, E);
                }
                if (L == 0) {
                    pg8::Gemm g{(const bf16*)(ws + WS_WHYIN) + (size_t)2048 * 1024, HA, 512, TOK, DM}; pg8::StaticOrder S; S.init(512, TOK, G, (int)blockIdx.x);
                    pg8::EpiBf16G<true> E{(bf16*)(ws + WS_VT), TOK, 0, ssqj, BIAS + BIAS_IN0 + 2048, 2560};
                    pg8::gemm_phase<pg8::EpiBf16G<true>, pg8::StaticOrder, true, true>(lds, g, S, E);
                    if (!rep) filler(A, ws, lds, p, G);
                }
            } else if (r == 3) {
                if (L == 0) phase_mixer0(A, lds, G); else phase_conv(A, G);
            } else {
                const int jn = j + 1, jc = jn > 5 ? 5 : jn, Ln = jc / 3, sn = jc % 3;
                const float* gn = A.in[4] + (size_t)jc * DM; const int goff = L * 4 * MODLD + (3 * s + 2) * DM, soff = Ln * 4 * MODLD + (3 * sn + 1) * DM;
                float* ssqn = SSQ + (size_t)jn * TOK;
                const bool dn = (s != 1); const int f = L * 2 + (s >> 1);
                const bf16* Ap = dn ? (const bf16*)(ws + WS_R1) : HA;
                const bf16* Bp = dn ? (const bf16*)(ws + WS_WD) + (size_t)f * 1024 * FF : (const bf16*)(ws + (L == 0 ? WS_WHYOUT : WS_WSCOUT));
                const pg8::Gemm g{Ap, Bp, TOK, DM, dn ? FF : DM};
                const pg8::EpiResid E{XB, XB, MOD, rep ? -98304 : goff, soff, dn ? HA : HB, gn, rep ? SSQ + 7 * TOK : ssqn};
                pg8::StaticOrder S; S.init(TOK, DM, G, (int)blockIdx.x);
                pg8::gemm_phase<pg8::EpiResid, pg8::StaticOrder, true, true>(lds, g, S, E);
            }
        }
      }
        if (p + 1 < A.hi) xcd_barrier(xbar);
    }
}

extern "C" void kernel_launch(void* const* d_in, const int* in_sizes, int n_in, void* d_out, int out_size, void* d_ws, size_t ws_size, hipStream_t stream) {
    static int grid = 0;
    if (grid == 0) {
        if (n_in != 17 || out_size != TOK * DM || ws_size < WS_END) { fprintf(stderr, "kernel_launch: unexpected shapes (n_in %d out %d ws %zu)\n", n_in, out_size, ws_size); grid = -1; return; }
        int dev = 0, cus = 0, per_cu = 0;
        (void)hipGetDevice(&dev); (void)hipDeviceGetAttribute(&cus, hipDeviceAttributeMultiprocessorCount, dev);
        if (hipFuncSetAttribute((const void*)mega_fwd, hipFuncAttributeMaxDynamicSharedMemorySize, LDS_BYTES) != hipSuccess) { fprintf(stderr, "kernel_launch: hipFuncSetAttribute failed\n"); grid = -1; return; }
        if (hipOccupancyMaxActiveBlocksPerMultiprocessor(&per_cu, (const void*)mega_fwd, NTHR, LDS_BYTES) != hipSuccess || per_cu < 1) { fprintf(stderr, "kernel_launch: occupancy query gave %d\n", per_cu); per_cu = 1; }
        (void)hipGetLastError();
        grid = cus * 1;
    }
    if (grid < 0) return;
    if (hipMemsetAsync(d_ws, 0, CTL_ZERO_BYTES, stream) != hipSuccess) { fprintf(stderr, "kernel_launch: memset failed\n"); return; }
    Args a{};
    for (int i = 0; i < 17; ++i) a.in[i] = (const float*)d_in[i];
    a.out = (float*)d_out; a.ws = (unsigned char*)d_ws;
    a.lo = 0; a.hi = N_PHASES; void* kargs[] = {&a};
    hipError_t e = hipLaunchCooperativeKernel((const void*)mega_fwd, dim3(grid), dim3(NTHR), kargs, LDS_BYTES, stream);
    if (e != hipSuccess) fprintf(stderr, "cooperative launch failed: %s (grid %d)\n", hipGetErrorString(e), grid);
}
```

```cpp
#include <hip/hip_runtime.h>
#include <hip/hip_cooperative_groups.h>
#include <cstdio>
#include <cstdint>
namespace cg = cooperative_groups;
namespace pg8 {
#define PG8_LAS __attribute__((address_space(3)))
typedef unsigned short bf16_t;
typedef short bf16x8 __attribute__((ext_vector_type(8)));
typedef float f32x4 __attribute__((ext_vector_type(4)));
typedef unsigned u32x4 __attribute__((ext_vector_type(4)));
constexpr int BM = 256, BK = 64, HALF = 128, HTB = HALF * BK * 2  , STAGE_BYTES = 8 * HTB, NXCD = 8, WGM = 8;

__host__ __device__ __forceinline__ int lds_byte(int r, int c) { const int st = (r >> 4) * 2 + (c >> 5), rr = r & 15, cc = c & 31, ob = rr * 64 + cc * 2; return st * 1024 + (ob ^ (((ob >> 9) & 1) << 5)); }
__host__ __device__ __forceinline__ void stage_rc(int b, int& R, int& C) { const int st = b / 1024, sb = b % 1024, swz = sb ^ (((sb >> 9) & 1) << 5); R = (st >> 1) * 16 + swz / 64; C = (st & 1) * 32 + (swz % 64) / 2; }
__host__ __device__ __forceinline__ int perm32(int rho) { const int n = rho >> 4, i = rho & 15; return 8 * (i >> 2) + 4 * n + (i & 3); }

struct Unit { int pm, pn; };
struct Gemm { const bf16_t* A; const bf16_t* Bt; int M, N, K; };

struct StaticOrder {
    int nM, nN, nwg, G, c;
    __host__ __device__ void init(int M, int N, int G_, int c_) { nM = M / BM; nN = N / BM; nwg = nM * nN; G = G_; c = c_; }
    __host__ __device__ bool next(int i, Unit& u) const {
        const long L = (long)i * G + c; if (L >= nwg) return false;
        int wgid = (int)L; { const int q = nwg / NXCD, r = nwg % NXCD, xcd = wgid % NXCD, off = wgid / NXCD; wgid = (xcd < r ? xcd * (q + 1) : r * (q + 1) + (xcd - r) * q) + off; }
        const int nig = WGM * nN, gid = wgid / nig, fm = gid * WGM, gsz = (nM - fm) < WGM ? (nM - fm) : WGM;
        u.pm = fm + ((wgid % nig) % gsz); u.pn = (wgid % nig) / gsz; return true;
    }
    __device__ __forceinline__ void a_ready(const Unit&) const {}
    __device__ __forceinline__ void done(const Unit&) const {}
};

__device__ __forceinline__ unsigned cvt_pk_bf16(float lo, float hi) { unsigned r; asm volatile("v_cvt_pk_bf16_f32 %0, %1, %2" : "=v"(r) : "v"(lo), "v"(hi)); return r; }
typedef float f32x2 __attribute__((ext_vector_type(2)));
__device__ __forceinline__ f32x2 gelu_pk(f32x2 v) {
    const f32x2 av = __builtin_elementwise_abs(v), d = av * 0.2316418882f + 1.0f;
    f32x2 t; t.x = __builtin_amdgcn_rcpf(d.x); t.y = __builtin_amdgcn_rcpf(d.y);
    f32x2 q = t * 0.5307027145f + (-0.7265760135f); q = q * t + 0.7107068705f; q = q * t + (-0.142248368f); q = q * t + 0.127414796f; q = q * t;
    const f32x2 s = (v * v) * (-0.72134752044f);
    f32x2 e; e.x = __builtin_amdgcn_exp2f(s.x); e.y = __builtin_amdgcn_exp2f(s.y);
    const f32x2 m = v * (q * e), r = v - m;
    f32x2 o; o.x = v.x < 0.f ? m.x : r.x; o.y = v.y < 0.f ? m.y : r.y; return o;
}

__device__ __forceinline__ float silu_f(float g) { return g * __builtin_amdgcn_rcpf(1.0f + __builtin_amdgcn_exp2f(-1.44269504f * g)); }
__device__ __forceinline__ float rstd_of(float ssq) { return __builtin_amdgcn_rsqf(ssq * (1.0f / 1024.0f) + 1e-6f); }
struct EpiSwiGLU {
    static constexpr bool PERM = true, AFTER_DRAIN = false;
    bf16_t* O; int ldc; const float* ssq; const float* bias;
    __device__ __forceinline__ void operator()(const f32x4 (&acc)[2][2][4][2], const Unit& u, int wr, int wc, int fr, int fq) const {
        const int row0 = u.pm * BM + wr * 64 + fr, col0 = u.pn * HALF + wc * 32 + 8 * fq;
        const float* bp = bias + (size_t)((u.pm * BM) >> 12) * 5632 + u.pn * BM + wc * 32 + 8 * fq;
        const f32x4 bg0 = *(const f32x4*)bp, bg1 = *(const f32x4*)(bp + 4), bu0 = *(const f32x4*)(bp + HALF), bu1 = *(const f32x4*)(bp + HALF + 4);
        float sq8[2][4];
#pragma unroll
        for (int ai = 0; ai < 2; ++ai)
#pragma unroll
            for (int m = 0; m < 4; ++m) sq8[ai][m] = ssq[row0 + ai * HALF + m * 16];
#pragma unroll
        for (int ai = 0; ai < 2; ++ai)
#pragma unroll
            for (int m = 0; m < 4; ++m) { const int row = row0 + ai * HALF + m * 16; bf16_t* rowp = O + (size_t)row * ldc + col0;
                const float rs = rstd_of(sq8[ai][m]);
                const f32x4 g0 = acc[ai][0][m][0] * rs + bg0, g1 = acc[ai][0][m][1] * rs + bg1, u0 = acc[ai][1][m][0] * rs + bu0, u1 = acc[ai][1][m][1] * rs + bu1;
                u32x4 w; w.x = cvt_pk_bf16(silu_f(g0[0]) * u0[0], silu_f(g0[1]) * u0[1]); w.y = cvt_pk_bf16(silu_f(g0[2]) * u0[2], silu_f(g0[3]) * u0[3]);
                w.z = cvt_pk_bf16(silu_f(g1[0]) * u1[0], silu_f(g1[1]) * u1[1]); w.w = cvt_pk_bf16(silu_f(g1[2]) * u1[2], silu_f(g1[3]) * u1[3]);
                *(u32x4*)rowp = w; }
    }
};
template <bool TR> struct EpiBf16G {
    static constexpr bool PERM = true, AFTER_DRAIN = false;
    bf16_t* O; int ldc; int gelu_tiles; const float* ssq; const float* bias; int bpitch;
    __device__ __forceinline__ void operator()(const f32x4 (&acc)[2][2][4][2], const Unit& u, int wr, int wc, int fr, int fq) const {
        const int row0 = u.pm * BM + wr * 64 + fr, col0 = u.pn * BM + wc * 32 + 8 * fq; const bool ge = u.pn < gelu_tiles, qs = gelu_tiles != 0 && (u.pn == 4 || u.pn == 5);
        f32x4 cv[2][2];
        const float* bp = bias + (size_t)(((TR ? u.pn : u.pm) * BM) >> 12) * bpitch;
#pragma unroll
        for (int bj = 0; bj < 2; ++bj)
#pragma unroll
            for (int n = 0; n < 2; ++n) {
                if (TR) { const f32x4 q = *(const f32x4*)(ssq + col0 + bj * HALF + 4 * n); cv[bj][n] = (f32x4){rstd_of(q[0]), rstd_of(q[1]), rstd_of(q[2]), rstd_of(q[3])}; }
                else cv[bj][n] = *(const f32x4*)(bp + col0 + bj * HALF + 4 * n);
            }
        float rv8[2][4];
#pragma unroll
        for (int ai = 0; ai < 2; ++ai)
#pragma unroll
            for (int m = 0; m < 4; ++m) { const int row = row0 + ai * HALF + m * 16; rv8[ai][m] = TR ? bp[row] : ssq[row]; }
#pragma unroll
        for (int ai = 0; ai < 2; ++ai)
#pragma unroll
            for (int m = 0; m < 4; ++m) { const int row = row0 + ai * HALF + m * 16; bf16_t* rowp = O + (size_t)row * ldc + col0;
                const float rv = TR ? rv8[ai][m] : rstd_of(rv8[ai][m]);
#pragma unroll
                for (int bj = 0; bj < 2; ++bj) { f32x4 v0, v1;
                    if (TR) { v0 = acc[ai][bj][m][0] * cv[bj][0] + rv; v1 = acc[ai][bj][m][1] * cv[bj][1] + rv; }
                    else { v0 = acc[ai][bj][m][0] * rv + cv[bj][0]; v1 = acc[ai][bj][m][1] * rv + cv[bj][1]; }
                    if (ge) { f32x2 a = gelu_pk((f32x2){v0[0], v0[1]}), b = gelu_pk((f32x2){v0[2], v0[3]}), c = gelu_pk((f32x2){v1[0], v1[1]}), d = gelu_pk((f32x2){v1[2], v1[3]});
                        v0 = (f32x4){a.x, a.y, b.x, b.y}; v1 = (f32x4){c.x, c.y, d.x, d.y}; }
                    if (!TR && qs) { v0 = v0 * (-0.125f * 1.44269504f); v1 = v1 * (-0.125f * 1.44269504f); }
                    u32x4 w; w.x = cvt_pk_bf16(v0[0], v0[1]); w.y = cvt_pk_bf16(v0[2], v0[3]); w.z = cvt_pk_bf16(v1[0], v1[1]); w.w = cvt_pk_bf16(v1[2], v1[3]);
                    *(u32x4*)(rowp + bj * HALF) = w; } }
    }
};
struct EpiResid {
    static constexpr bool PERM = true, AFTER_DRAIN = false;
    const bf16_t* xin; bf16_t* xout; const float* mod; int goff, soff; bf16_t* XS; const float* gn; float* ssq;
    template <int AI, int M0> __device__ __forceinline__ void ld(u32x4 (&r)[2][2], int row0, int col0) const {
#pragma unroll
        for (int m = 0; m < 2; ++m)
#pragma unroll
            for (int bj = 0; bj < 2; ++bj) r[m][bj] = *(const u32x4*)(xin + (size_t)(row0 + AI * HALF + (M0 + m) * 16) * 1024 + col0 + bj * HALF);
    }
    template <int AI, int M0> __device__ __forceinline__ void cp(f32x4 (&y)[2][2][2], const u32x4 (&r)[2][2], const f32x4 (&acc)[2][2][4][2], const f32x4 (&gv)[2][2]) const {
#pragma unroll
        for (int m = 0; m < 2; ++m)
#pragma unroll
            for (int bj = 0; bj < 2; ++bj) { const u32x4 q = r[m][bj];
                const f32x4 x0 = {__uint_as_float(q.x << 16), __uint_as_float(q.x & 0xffff0000u), __uint_as_float(q.y << 16), __uint_as_float(q.y & 0xffff0000u)};
                const f32x4 x1 = {__uint_as_float(q.z << 16), __uint_as_float(q.z & 0xffff0000u), __uint_as_float(q.w << 16), __uint_as_float(q.w & 0xffff0000u)};
                y[m][bj][0] = x0 + gv[bj][0] * acc[AI][bj][M0 + m][0]; y[m][bj][1] = x1 + gv[bj][1] * acc[AI][bj][M0 + m][1]; }
    }
    template <int AI, int M0> __device__ __forceinline__ void st(const f32x4 (&y)[2][2][2], const f32x4 (&gs)[2][2], int row0, int col0, int fq) const {
#pragma unroll
        for (int m = 0; m < 2; ++m) { const int row = row0 + AI * HALF + (M0 + m) * 16; float sq = 0.f;
#pragma unroll
            for (int bj = 0; bj < 2; ++bj) { const size_t off = (size_t)row * 1024 + col0 + bj * HALF; const f32x4 y0 = y[m][bj][0], y1 = y[m][bj][1];
                u32x4 xw; xw.x = cvt_pk_bf16(y0[0], y0[1]); xw.y = cvt_pk_bf16(y0[2], y0[3]); xw.z = cvt_pk_bf16(y1[0], y1[1]); xw.w = cvt_pk_bf16(y1[2], y1[3]);
                *(u32x4*)(xout + off) = xw;
                sq += (y0[0] * y0[0] + y0[1] * y0[1]) + (y0[2] * y0[2] + y0[3] * y0[3]) + (y1[0] * y1[0] + y1[1] * y1[1]) + (y1[2] * y1[2] + y1[3] * y1[3]);
                const f32x4 s0 = y0 * gs[bj][0], s1 = y1 * gs[bj][1];
                u32x4 w; w.x = cvt_pk_bf16(s0[0], s0[1]); w.y = cvt_pk_bf16(s0[2], s0[3]); w.z = cvt_pk_bf16(s1[0], s1[1]); w.w = cvt_pk_bf16(s1[2], s1[3]);
                *(u32x4*)(XS + off) = w; }
            sq += __shfl_xor(sq, 16); sq += __shfl_xor(sq, 32);
            if (fq == 0) (void)__hip_atomic_fetch_add(ssq + row, sq, __ATOMIC_RELAXED, __HIP_MEMORY_SCOPE_AGENT); }
    }
    __device__ __forceinline__ void operator()(const f32x4 (&acc)[2][2][4][2], const Unit& u, int wr, int wc, int fr, int fq) const {
        const int row0 = u.pm * BM + wr * 64 + fr, col0 = u.pn * BM + wc * 32 + 8 * fq; const float* mb = mod + (size_t)((u.pm * BM) >> 12) * 9216 + col0;
        u32x4 ra[2][2], rb[2][2]; f32x4 y[2][2][2];
        ld<0, 0>(ra, row0, col0);
        f32x4 gv[2][2], gs[2][2];
#pragma unroll
        for (int bj = 0; bj < 2; ++bj)
#pragma unroll
            for (int n = 0; n < 2; ++n) { gv[bj][n] = *(const f32x4*)(mb + goff + bj * HALF + 4 * n);
                gs[bj][n] = *(const f32x4*)(gn + col0 + bj * HALF + 4 * n) * (*(const f32x4*)(mb + soff + bj * HALF + 4 * n) + 1.0f); }
        cp<0, 0>(y, ra, acc, gv); ld<0, 2>(rb, row0, col0); st<0, 0>(y, gs, row0, col0, fq);
        cp<0, 2>(y, rb, acc, gv); ld<1, 0>(ra, row0, col0); st<0, 2>(y, gs, row0, col0, fq);
        cp<1, 0>(y, ra, acc, gv); ld<1, 2>(rb, row0, col0); st<1, 0>(y, gs, row0, col0, fq);
        cp<1, 2>(y, rb, acc, gv); st<1, 2>(y, gs, row0, col0, fq);
    }
};

template <class Epi, class Sched, bool ALIGN_EPI = false, bool SP2 = false>
__device__ __forceinline__ void gemm_phase(PG8_LAS unsigned char* lds, const Gemm g, const Sched& S, const Epi& E) {
    int tid_ = threadIdx.x; asm volatile("" : "+v"(tid_)); const int tid = tid_, wid = __builtin_amdgcn_readfirstlane(tid >> 6), lane = tid & 63, wr = wid >> 2, wc = wid & 3, fr = lane & 15, fq = lane >> 4;
    const int K = g.K, nt = K / BK;
    unsigned voffA[2], voffB[2];
#pragma unroll
    for (int i = 0; i < 2; ++i) { int R, C; stage_rc(tid * 16 + i * 8192, R, C); const int Rb = Epi::PERM ? ((R & ~31) + perm32(R & 31)) : R;
        voffA[i] = (unsigned)(R * K + C) * 2u; voffB[i] = (unsigned)(Rb * K + C) * 2u; }
    const size_t kstep = (size_t)(BK * 2);
    const size_t hstep = (size_t)HALF * K * 2;
    const size_t tstep = 2 * hstep;
    const unsigned ldsw = (unsigned)wid * 1024u;
    const int aoff = lds_byte(wr * 64 + fr, fq * 8), boff = lds_byte(wc * 32 + fr, fq * 8);
#define PG8_SA(b, h) (((b) * 2 + (h)) * HTB)
#define PG8_SB(b, h) ((4 + (b) * 2 + (h)) * HTB)
#define PG8_STAGE(bufoff, gbase, voff) do { _Pragma("unroll") for (int _i = 0; _i < 2; ++_i) \
        __builtin_amdgcn_global_load_lds((const unsigned*)((const char*)(gbase) + (voff)[_i]), (PG8_LAS unsigned*)(lds + (bufoff) + ldsw + _i * 8192), 16, 0, 0); } while (0)
#define PG8_LDA(dst, b, h) do { _Pragma("unroll") for (int m = 0; m < 4; ++m) _Pragma("unroll") for (int k = 0; k < 2; ++k) dst[m][k] = *(const PG8_LAS bf16x8*)(lds + PG8_SA(b, h) + aoff + m * 2048 + k * 1024); } while (0)
#define PG8_LDB(dst, b, h) do { _Pragma("unroll") for (int n = 0; n < 2; ++n) _Pragma("unroll") for (int k = 0; k < 2; ++k) dst[n][k] = *(const PG8_LAS bf16x8*)(lds + PG8_SB(b, h) + boff + n * 2048 + k * 1024); } while (0)
#define PG8_MMA(ai, bj, At, Bt) do { __builtin_amdgcn_s_setprio(1); _Pragma("unroll") for (int m = 0; m < 4; ++m) _Pragma("unroll") for (int n = 0; n < 2; ++n) _Pragma("unroll") for (int k = 0; k < 2; ++k) \
        acc[ai][bj][m][n] = __builtin_amdgcn_mfma_f32_16x16x32_bf16(Bt[n][k], At[m][k], acc[ai][bj][m][n], 0, 0, 0); __builtin_amdgcn_s_setprio(0); } while (0)
#define PG8_WAIT_V(n) asm volatile("s_waitcnt vmcnt(" #n ")" ::: "memory")
#define PG8_WAIT_L(n) asm volatile("s_waitcnt lgkmcnt(" #n ")" ::: "memory")
#define PG8_BAR __builtin_amdgcn_s_barrier()
#define PG8_SCHED __builtin_amdgcn_sched_barrier(0)
    Unit cur, nxt; int ui = 0;
    if (!S.next(0, cur)) return;
    f32x4 acc[2][2][4][2];
#pragma unroll
    for (int a = 0; a < 2; ++a)
#pragma unroll
        for (int b = 0; b < 2; ++b)
#pragma unroll
            for (int m = 0; m < 4; ++m)
#pragma unroll
                for (int n = 0; n < 2; ++n) acc[a][b][m][n] = (f32x4){0.f, 0.f, 0.f, 0.f};
    bf16x8 At[4][2], B0[2][2], B1[2][2];
    const char* cA = (const char*)g.A + (size_t)cur.pm * tstep; const char* cB = (const char*)g.Bt + (size_t)cur.pn * tstep;
    S.a_ready(cur);
    if constexpr (SP2) {
        PG8_STAGE(PG8_SB(0, 0), cB, voffB); PG8_STAGE(PG8_SB(0, 1), cB + hstep, voffB); PG8_STAGE(PG8_SA(0, 0), cA, voffA); PG8_STAGE(PG8_SA(0, 1), cA + hstep, voffA);
        if (wr == 1) PG8_BAR;
        PG8_WAIT_V(2); PG8_BAR;
        PG8_STAGE(PG8_SB(1, 0), cB + kstep, voffB); PG8_STAGE(PG8_SA(1, 0), cA + kstep, voffA); PG8_STAGE(PG8_SB(1, 1), cB + hstep + kstep, voffB);
        PG8_WAIT_V(6); PG8_BAR;
    } else {
        PG8_STAGE(PG8_SB(0, 0), cB, voffB); PG8_STAGE(PG8_SA(0, 0), cA, voffA); PG8_STAGE(PG8_SB(0, 1), cB + hstep, voffB); PG8_STAGE(PG8_SA(0, 1), cA + hstep, voffA);
        if (wr == 1) PG8_BAR;
        PG8_WAIT_V(4); PG8_BAR;
        PG8_STAGE(PG8_SB(1, 0), cB + kstep, voffB); PG8_STAGE(PG8_SA(1, 0), cA + kstep, voffA); PG8_STAGE(PG8_SB(1, 1), cB + hstep + kstep, voffB);
        PG8_WAIT_V(6); PG8_BAR;
    }
    for (;;) {
        const bool has_next = S.next(ui + 1, nxt);
        const char* nA = has_next ? (const char*)g.A + (size_t)nxt.pm * tstep : cA; const char* nB = has_next ? (const char*)g.Bt + (size_t)nxt.pn * tstep : cB;
        for (int t = 0; t < nt; t += 2) {
            const bool last = (t == nt - 2);
            const char* a1 = cA + (size_t)(t + 1) * kstep;
            const char* a2 = last ? nA : cA + (size_t)(t + 2) * kstep; const char* b2 = last ? nB : cB + (size_t)(t + 2) * kstep;
            const char* a3 = a2 + kstep; const char* b3 = b2 + kstep;
            if (last && has_next) S.a_ready(nxt);
            if constexpr (SP2) {
            PG8_LDB(B0, 0, 0); PG8_LDB(B1, 0, 1); PG8_SCHED; PG8_LDA(At, 0, 0); PG8_STAGE(PG8_SA(1, 1), a1 + hstep, voffA);
            PG8_WAIT_V(8); PG8_WAIT_L(0); PG8_BAR; PG8_MMA(0, 0, At, B0); PG8_MMA(0, 1, At, B1); PG8_BAR; PG8_SCHED;
            PG8_LDA(At, 0, 1); PG8_STAGE(PG8_SB(0, 0), b2, voffB); PG8_STAGE(PG8_SB(0, 1), b2 + hstep, voffB); PG8_STAGE(PG8_SA(0, 0), a2, voffA);
            PG8_WAIT_V(8); PG8_WAIT_L(0); PG8_BAR; PG8_MMA(1, 0, At, B0); PG8_MMA(1, 1, At, B1); PG8_BAR; PG8_SCHED;
            PG8_LDB(B0, 1, 0); PG8_LDB(B1, 1, 1); PG8_SCHED; PG8_LDA(At, 1, 0); PG8_STAGE(PG8_SA(0, 1), a2 + hstep, voffA);
            PG8_WAIT_V(8); PG8_WAIT_L(0); PG8_BAR; PG8_MMA(0, 0, At, B0); PG8_MMA(0, 1, At, B1); PG8_BAR; PG8_SCHED;
            PG8_LDA(At, 1, 1); PG8_STAGE(PG8_SB(1, 0), b3, voffB); PG8_STAGE(PG8_SB(1, 1), b3 + hstep, voffB); PG8_STAGE(PG8_SA(1, 0), a3, voffA);
            PG8_WAIT_V(8); PG8_WAIT_L(0); PG8_BAR; PG8_MMA(1, 0, At, B0); PG8_MMA(1, 1, At, B1); PG8_BAR; PG8_SCHED;
            } else {
            PG8_LDB(B0, 0, 0); PG8_SCHED; PG8_LDA(At, 0, 0); PG8_STAGE(PG8_SA(1, 1), a1 + hstep, voffA);
            PG8_WAIT_L(8); PG8_BAR; PG8_WAIT_L(0); PG8_MMA(0, 0, At, B0); PG8_BAR; PG8_SCHED;
            PG8_LDB(B1, 0, 1); PG8_STAGE(PG8_SB(0, 0), b2, voffB);
            PG8_BAR; PG8_WAIT_L(0); PG8_MMA(0, 1, At, B1); PG8_BAR;
            PG8_LDA(At, 0, 1); PG8_STAGE(PG8_SA(0, 0), a2, voffA);
            PG8_BAR; PG8_WAIT_L(0); PG8_MMA(1, 0, At, B0); PG8_BAR; PG8_SCHED;
            PG8_STAGE(PG8_SB(0, 1), b2 + hstep, voffB);
            PG8_WAIT_V(6); PG8_BAR; PG8_MMA(1, 1, At, B1); PG8_BAR;
            PG8_LDB(B0, 1, 0); PG8_SCHED; PG8_LDA(At, 1, 0); PG8_STAGE(PG8_SA(0, 1), a2 + hstep, voffA);
            PG8_WAIT_L(8); PG8_BAR; PG8_WAIT_L(0); PG8_MMA(0, 0, At, B0); PG8_BAR; PG8_SCHED;
            PG8_LDB(B1, 1, 1); PG8_STAGE(PG8_SB(1, 0), b3, voffB);
            PG8_BAR; PG8_WAIT_L(0); PG8_MMA(0, 1, At, B1); PG8_BAR;
            PG8_LDA(At, 1, 1); PG8_STAGE(PG8_SA(1, 0), a3, voffA);
            PG8_BAR; PG8_WAIT_L(0); PG8_MMA(1, 0, At, B0); PG8_BAR; PG8_SCHED;
            PG8_STAGE(PG8_SB(1, 1), b3 + hstep, voffB);
            PG8_WAIT_V(6); PG8_BAR; PG8_MMA(1, 1, At, B1); PG8_BAR;
            }
        }
        if constexpr (ALIGN_EPI) { if (wr == 0) PG8_BAR; }
        if constexpr (!Epi::AFTER_DRAIN) { E(acc, cur, wr, wc, fr, fq); S.done(cur); }
        if (!has_next) break;
#pragma unroll
        for (int a = 0; a < 2; ++a)
#pragma unroll
            for (int b = 0; b < 2; ++b)
#pragma unroll
                for (int m = 0; m < 4; ++m)
#pragma unroll
                    for (int n = 0; n < 2; ++n) acc[a][b][m][n] = (f32x4){0.f, 0.f, 0.f, 0.f};
        cur = nxt; cA = nA; cB = nB; ++ui;
        if constexpr (ALIGN_EPI) { if (wr == 1) PG8_BAR; }
    }
    PG8_WAIT_V(0);
    if constexpr (!ALIGN_EPI) { if (wr == 0) PG8_BAR; }
    PG8_BAR;
    if constexpr (Epi::AFTER_DRAIN) { E.fused(acc, cur, wr, wc, fr, fq, lds, wid, lane); S.done(cur); }
#undef PG8_SA
#undef PG8_SB
#undef PG8_STAGE
#undef PG8_LDA
#undef PG8_LDB
#undef PG8_MMA
#undef PG8_WAIT_V
#undef PG8_WAIT_L
#undef PG8_BAR
#undef PG8_SCHED
}
}

#ifndef PROBE_MASK
#define PROBE_MASK 0
#endif
#ifndef PROBE_N
#define PROBE_N 1
#endif
constexpr int NWAVES = 8, NTHR = 512;
constexpr int TOK = 16384, SEQ = 4096, DM = 1024, FF = 2816, MODLD = 9216;
constexpr float EPS = 1e-6f;
constexpr size_t MiB = 1u << 20;
constexpr size_t WS_BAR = 0;
constexpr size_t WS_SSQ = 64 * 1024;
constexpr size_t CTL_ZERO_BYTES = 512 * 1024;
constexpr size_t WS_MOD = 1 * MiB;
constexpr size_t WS_BIAS = WS_MOD + 512 * 1024;
constexpr int BIAS_IN0 = 4 * 4 * 5632, BIAS_IN1 = BIAS_IN0 + 4 * 2560;
constexpr size_t WS_WGU = 2 * MiB;
constexpr size_t WS_WD = 46 * MiB;
constexpr size_t WS_WHYIN = 68 * MiB;
constexpr size_t WS_WHYOUT = 73 * MiB;
constexpr size_t WS_WSCIN = 75 * MiB;
constexpr size_t WS_WSCOUT = 81 * MiB;
constexpr size_t WS_H = 83 * MiB;
constexpr size_t WS_R1 = 115 * MiB;
constexpr size_t WS_VT = WS_R1 + 64 * MiB;
constexpr size_t WS_HB = 211 * MiB;
constexpr size_t WS_XB = 243 * MiB;
constexpr size_t WS_END = 275 * MiB;
constexpr int LDS_BYTES = 131072 + 1024;

#define GAS __attribute__((address_space(1)))
#define LAS __attribute__((address_space(3)))
typedef unsigned short bf16;
typedef unsigned v4u __attribute__((ext_vector_type(4)));
typedef unsigned v2u __attribute__((ext_vector_type(2)));
typedef float f32x4 __attribute__((ext_vector_type(4)));
typedef float f32x16 __attribute__((ext_vector_type(16)));
typedef short bf16x8 __attribute__((ext_vector_type(8)));
#define LDS_WAIT() asm volatile("s_waitcnt lgkmcnt(0)" ::: "memory")

__device__ __forceinline__ unsigned pk2(float lo, float hi) { return pg8::cvt_pk_bf16(lo, hi); }
__device__ __forceinline__ float bf2f(unsigned short v) { return __uint_as_float((unsigned)v << 16); }
__device__ __forceinline__ float bflo(unsigned w) { return __uint_as_float(w << 16); }
__device__ __forceinline__ float bfhi(unsigned w) { return __uint_as_float(w & 0xffff0000u); }
__device__ __forceinline__ float wave_sum(float v) {
#pragma unroll
    for (int o = 1; o < 64; o <<= 1) v += __shfl_xor(v, o);
    return v;
}

#define XB_TMO      128
#define XB_XCNT(j)  (256  + 64 * (j))
#define XB_XSUB(j)  (1280 + 64 * (j))
#define XB_XGEN(j)  (2304 + 64 * (j))
#define XB_TOP      3328
#define XB_TOPGEN   3392
#define XCD_BAR_WORDS 3456
#define XB_SPIN_CAP (1u << 18)

__device__ __forceinline__ unsigned xb_ld(unsigned* p)              { return __hip_atomic_load(p, __ATOMIC_RELAXED, __HIP_MEMORY_SCOPE_AGENT); }
__device__ __forceinline__ unsigned xb_add(unsigned* p, unsigned v) { return __hip_atomic_fetch_add(p, v, __ATOMIC_RELAXED, __HIP_MEMORY_SCOPE_AGENT); }
__device__ __forceinline__ unsigned xb_xcc_id() { return (unsigned)__builtin_amdgcn_s_getreg((3 << 11) | 20) & 0xFu; }
#define XB_SPIN(cond, bar) do { unsigned _sp = 0; while (cond) { __builtin_amdgcn_s_sleep(1); \
    if ((++_sp & 255u) == 0u) { if (xb_ld(&(bar)[XB_TMO])) break; if (_sp > XB_SPIN_CAP) { atomicAdd(&(bar)[XB_TMO], 1u); break; } } } } while (0)

struct XcdBarrier {
    unsigned* bar; unsigned x;
    volatile LAS unsigned* st;
};

__device__ __forceinline__ XcdBarrier xcd_barrier_post(unsigned* bar, volatile LAS unsigned* st) {
    XcdBarrier b; b.bar = bar; b.x = xb_xcc_id(); b.st = st;
    if (threadIdx.x == 0) (void)xb_add(&bar[XB_XCNT(b.x)], 1u);
    return b;
}
__device__ __forceinline__ void xcd_barrier_complete(unsigned* bar, unsigned x, unsigned& nloc, unsigned& nx) {
    const unsigned G = gridDim.x * gridDim.y * gridDim.z;
    unsigned sum, cnt, mine, sp = 0u;
    for (;;) {
        sum = 0u; cnt = 0u; mine = 0u;
#pragma unroll
        for (unsigned j = 0; j < 16; ++j) { const unsigned c = xb_ld(&bar[XB_XCNT(j)]); sum += c; cnt += (c > 0u) ? 1u : 0u; mine = (j == x) ? c : mine; }
        if (sum == G) break;
        __builtin_amdgcn_s_sleep(1);
        if ((++sp & 255u) == 0u) { if (xb_ld(&bar[XB_TMO])) break; if (sp > XB_SPIN_CAP) { atomicAdd(&bar[XB_TMO], 1u); break; } }
    }
    nloc = mine > 0u ? mine : 1u; nx = cnt > 0u ? cnt : 1u;
}

__device__ __forceinline__ void xcd_barrier(const XcdBarrier& b) {
    asm volatile("s_waitcnt vmcnt(0)" ::: "memory");
    __syncthreads();
    if (threadIdx.x == 0) {
        unsigned* bar = b.bar;
        __builtin_amdgcn_s_waitcnt(0);
        unsigned nloc = b.st[0], nx = b.st[1];
        if (nloc == 0u) { xcd_barrier_complete(bar, b.x, nloc, nx); b.st[0] = nloc; b.st[1] = nx; }
        const unsigned old = xb_add(&bar[XB_XSUB(b.x)], 1u);
        const unsigned gen = old / nloc;
        if (old + 1u == (gen + 1u) * nloc) {
            __builtin_amdgcn_fence(__ATOMIC_RELEASE, "agent");
            asm volatile("s_waitcnt vmcnt(0)" ::: "memory");
            const unsigned og = xb_add(&bar[XB_TOP], 1u);
            const unsigned tg = og / nx;
            if (og + 1u == (tg + 1u) * nx) xb_add(&bar[XB_TOPGEN], 1u);
            else XB_SPIN(xb_ld(&bar[XB_TOPGEN]) == tg, bar);
            __builtin_amdgcn_fence(__ATOMIC_ACQUIRE, "agent");
            xb_add(&bar[XB_XGEN(b.x)], 1u);
            asm volatile("s_waitcnt vmcnt(0)" ::: "memory");
        } else {
            XB_SPIN(xb_ld(&bar[XB_XGEN(b.x)]) == gen, bar);
            __builtin_amdgcn_fence(__ATOMIC_ACQUIRE, "agent");
            asm volatile("s_waitcnt vmcnt(0)" ::: "memory");
        }
    }
    __syncthreads();
}

struct Args { const float* in[17]; float* out; unsigned char* ws; int lo, hi; };

struct TrItem { const float* src; bf16* dst; int N, K; };
__device__ __forceinline__ TrItem tr_make(const float* W, int K, int N, bf16* WT, int kind, int item) {
    const int nblk = N / 32, kb = item / nblk, nb = item % nblk, k0 = 64 * kb, n0 = 32 * nb;
    int orow0 = n0; if (kind == 1) orow0 = 256 * (n0 >> 7) + (n0 & 127); else if (kind == 2) orow0 = 256 * (n0 >> 7) + 128 + (n0 & 127);
    TrItem t; t.src = W + (size_t)k0 * N + n0; t.dst = WT + (size_t)orow0 * K + k0; t.N = N; t.K = K; return t;
}
__device__ __forceinline__ int mat_items(int id) { return id < 0 ? 0 : (id < 4 ? 2816 : (id < 8 ? 1408 : (id == 8 ? 1280 : (id == 10 ? 1536 : 512)))); }
__device__ __forceinline__ TrItem tr_decode_mat(const Args& A, unsigned char* ws, int id, int r) {
    if (id < 4) { if (r < 1408) return tr_make(A.in[5] + (size_t)id * DM * FF, DM, FF, (bf16*)(ws + WS_WGU) + (size_t)id * 5632 * 1024, 1, r);
                  return tr_make(A.in[6] + (size_t)id * DM * FF, DM, FF, (bf16*)(ws + WS_WGU) + (size_t)id * 5632 * 1024, 2, r - 1408); }
    if (id < 8) return tr_make(A.in[7] + (size_t)(id - 4) * FF * DM, FF, DM, (bf16*)(ws + WS_WD) + (size_t)(id - 4) * 1024 * FF, 0, r);
    if (id == 8) return tr_make(A.in[8], DM, 2560, (bf16*)(ws + WS_WHYIN), 0, r);
    if (id == 9) return tr_make(A.in[9], DM, DM, (bf16*)(ws + WS_WHYOUT), 0, r);
    if (id == 10) return tr_make(A.in[13], DM, 3072, (bf16*)(ws + WS_WSCIN), 0, r);
    return tr_make(A.in[15], DM, DM, (bf16*)(ws + WS_WSCOUT), 0, r);
}
__device__ __forceinline__ void slot_mats(int sel, int& m0, int& m1, int& m2) {
    m0 = (sel == 0) ? 0 : (sel == 1) ? 4 : (sel == 2) ? 5 : (sel == 3) ? 3 : 6;
    m1 = (sel == 0) ? 8 : (sel == 1) ? 1 : (sel == 2) ? 2 : (sel == 3) ? 10 : 7;
    m2 = (sel == 1) ? 9 : (sel == 4) ? 11 : -1;
}
__device__ __forceinline__ TrItem tr_decode(const Args& A, unsigned char* ws, int sel, int it) {
    int m0, m1, m2; slot_mats(sel, m0, m1, m2);
    const int n0 = mat_items(m0), n1 = mat_items(m1);
    if (it < n0) return tr_decode_mat(A, ws, m0, it);
    if (it < n0 + n1) return tr_decode_mat(A, ws, m1, it - n0);
    return tr_decode_mat(A, ws, m2, it - n0 - n1);
}
__device__ __forceinline__ void convert_items(const Args& A, unsigned char* ws, LAS float* scr, int sel, int gw, int NGW, int lane) {
    int sm0, sm1, sm2; slot_mats(sel, sm0, sm1, sm2);
    const int nitems = mat_items(sm0) + mat_items(sm1) + mat_items(sm2);
    int it = gw;
    if (it >= nitems) return;
    const int l5 = lane >> 5, l31 = lane & 31, c = lane & 7, nj = lane >> 3;
    TrItem cur = tr_decode(A, ws, sel, it);
    float tv[32];
#pragma unroll
    for (int i = 0; i < 32; ++i) tv[i] = __builtin_nontemporal_load(cur.src + (size_t)(2 * i + l5) * cur.N + l31);
    for (;;) {
#pragma unroll
        for (int i = 0; i < 32; ++i) scr[(2 * i + l5) * 33 + l31] = tv[i];
        const int itn = it + NGW; const bool more = itn < nitems;
        const TrItem nxt = tr_decode(A, ws, sel, more ? itn : it);
#pragma unroll
        for (int i = 0; i < 32; ++i) tv[i] = __builtin_nontemporal_load(nxt.src + (size_t)(2 * i + l5) * nxt.N + l31);
        LDS_WAIT(); asm volatile("" ::: "memory");
#pragma unroll
        for (int j = 0; j < 4; ++j) { const int n = nj + 8 * j; const LAS float* sp = scr + (8 * c) * 33 + n;
            v4u o; o.x = pk2(sp[0 * 33], sp[1 * 33]); o.y = pk2(sp[2 * 33], sp[3 * 33]); o.z = pk2(sp[4 * 33], sp[5 * 33]); o.w = pk2(sp[6 * 33], sp[7 * 33]);
            *(v4u*)(cur.dst + (size_t)n * cur.K + 8 * c) = o; }
        LDS_WAIT(); asm volatile("" ::: "memory");
        if (!more) break;
        cur = nxt; it = itn;
    }
}
__device__ __forceinline__ void phase_prologue(const Args& A, LAS unsigned char* lds, int G) {
    int tid_ = threadIdx.x; asm volatile("" : "+v"(tid_)); const int tid = tid_, lane = tid & 63, wid = tid >> 6;
    unsigned char* ws = A.ws;
    {
        LAS float* cs = (LAS float*)lds;
        LAS float* part = (LAS float*)(lds + 16384);
        const float* cin = A.in[1];
        for (int i = tid; i < 4096; i += NTHR) { const float c = cin[i]; cs[i] = c / (1.0f + __expf(-c)); }
        __syncthreads();
        const float* mod_w = A.in[2]; const float* mod_b = A.in[3]; float* MOD = (float*)(ws + WS_MOD);
        const int col = lane & 31, kg = wid * 2 + (lane >> 5);
        for (int unit = blockIdx.x; unit < 576; unit += G) {
            const int L = unit / 288, n0 = (unit % 288) * 32;
            const float* W = mod_w + (size_t)L * 1024 * MODLD + (size_t)(64 * kg) * MODLD + n0 + col;
            float a0 = 0.f, a1 = 0.f, a2 = 0.f, a3 = 0.f;
#pragma unroll 16
            for (int k = 0; k < 64; ++k) { const float w = __builtin_nontemporal_load(W + (size_t)k * MODLD); const int kk = 64 * kg + k;
                a0 += cs[kk] * w; a1 += cs[1024 + kk] * w; a2 += cs[2048 + kk] * w; a3 += cs[3072 + kk] * w; }
            part[(kg * 4 + 0) * 32 + col] = a0; part[(kg * 4 + 1) * 32 + col] = a1; part[(kg * 4 + 2) * 32 + col] = a2; part[(kg * 4 + 3) * 32 + col] = a3;
            __syncthreads();
            if (tid < 128) { const int b = tid >> 5, c = tid & 31; float s = mod_b[L * MODLD + n0 + c];
#pragma unroll
                for (int g = 0; g < 16; ++g) s += part[(g * 4 + b) * 32 + c];
                const int seg = (n0 + c) >> 10; if (seg == 2 || seg == 8) s *= 0.5f;
                MOD[(size_t)(L * 4 + b) * MODLD + n0 + c] = s; }
            __syncthreads();
        }
    }
    convert_items(A, ws, (LAS float*)(lds + wid * 16384), 0, blockIdx.x * NWAVES + wid, G * NWAVES, lane);
}

__device__ __forceinline__ void phase_norm0(const float* x, const float* g, const float* scale, bf16* XS, bf16* XB, float* ssq, int G) {
    int tid_ = threadIdx.x; asm volatile("" : "+v"(tid_)); const int tid = tid_, lane = tid & 63, wid = tid >> 6;
    const int gw = blockIdx.x * NWAVES + wid, NGW = G * NWAVES;
    f32x4 gv[4];
#pragma unroll
    for (int j = 0; j < 4; ++j) gv[j] = ((const f32x4*)g)[64 * j + lane];
    const bool aff = (G == 256);
    const int mstep = aff ? 256 : NGW; int m = aff ? 2048 * ((int)blockIdx.x & 7) + ((int)blockIdx.x >> 3) * NWAVES + wid : gw;
    int left = aff ? 8 : (gw < TOK ? (TOK - gw + NGW - 1) / NGW : 0);
    if (left == 0) return;
    f32x4 v[4];
#pragma unroll
    for (int j = 0; j < 4; ++j) v[j] = __builtin_nontemporal_load((const f32x4*)(x + (size_t)m * DM) + 64 * j + lane);
    for (;;) {
        const int mn = m + mstep; const bool more = left > 1; const int ml = more ? mn : m; --left;
        f32x4 nv[4];
#pragma unroll
        for (int j = 0; j < 4; ++j) nv[j] = __builtin_nontemporal_load((const f32x4*)(x + (size_t)ml * DM) + 64 * j + lane);
        const int b = m >> 12; float s = 0.f;
#pragma unroll
        for (int j = 0; j < 4; ++j) s += (v[j].x * v[j].x + v[j].y * v[j].y) + (v[j].z * v[j].z + v[j].w * v[j].w);
        s = wave_sum(s);
        if (lane == 0) ssq[m] = s;
        unsigned long long* o8 = (unsigned long long*)(XS + (size_t)m * DM) + lane; unsigned long long* x8 = (unsigned long long*)(XB + (size_t)m * DM) + lane;
#pragma unroll
        for (int j = 0; j < 4; ++j) {
            const f32x4 sc = ((const f32x4*)(scale + (size_t)b * MODLD))[64 * j + lane];
            const f32x4 y = v[j] * gv[j] * (sc + 1.0f);
            o8[64 * j] = (unsigned long long)pk2(y.x, y.y) | ((unsigned long long)pk2(y.z, y.w) << 32);
            x8[64 * j] = (unsigned long long)pk2(v[j].x, v[j].y) | ((unsigned long long)pk2(v[j].z, v[j].w) << 32);
        }
        if (!more) break;
#pragma unroll
        for (int j = 0; j < 4; ++j) v[j] = nv[j];
        m = mn;
    }
}
__device__ __forceinline__ void bias_rows(const bf16* Wt, int nrows, const float* shift, float* out, int pitch, int gw, int NGW, int lane) {
    f32x4 sh[4][4];
#pragma unroll
    for (int b = 0; b < 4; ++b)
#pragma unroll
        for (int q = 0; q < 4; ++q) sh[b][q] = *(const f32x4*)(shift + (size_t)b * MODLD + 16 * lane + 4 * q);
    for (int n = gw; n < nrows; n += 2 * NGW) {
        const int n2 = n + NGW; const bool has2 = n2 < nrows; const int n2c = has2 ? n2 : n;
        const v4u w0 = *(const v4u*)(Wt + (size_t)n * DM + 16 * lane), w1 = *(const v4u*)(Wt + (size_t)n * DM + 16 * lane + 8);
        const v4u x0 = *(const v4u*)(Wt + (size_t)n2c * DM + 16 * lane), x1 = *(const v4u*)(Wt + (size_t)n2c * DM + 16 * lane + 8);
        const f32x4 f0 = {bflo(w0.x), bfhi(w0.x), bflo(w0.y), bfhi(w0.y)}, f1 = {bflo(w0.z), bfhi(w0.z), bflo(w0.w), bfhi(w0.w)};
        const f32x4 f2 = {bflo(w1.x), bfhi(w1.x), bflo(w1.y), bfhi(w1.y)}, f3 = {bflo(w1.z), bfhi(w1.z), bflo(w1.w), bfhi(w1.w)};
        const f32x4 g0 = {bflo(x0.x), bfhi(x0.x), bflo(x0.y), bfhi(x0.y)}, g1 = {bflo(x0.z), bfhi(x0.z), bflo(x0.w), bfhi(x0.w)};
        const f32x4 g2 = {bflo(x1.x), bfhi(x1.x), bflo(x1.y), bfhi(x1.y)}, g3 = {bflo(x1.z), bfhi(x1.z), bflo(x1.w), bfhi(x1.w)};
        float acc[4], acd[4];
#pragma unroll
        for (int b = 0; b < 4; ++b) { const f32x4 t = sh[b][0] * f0 + sh[b][1] * f1 + sh[b][2] * f2 + sh[b][3] * f3; acc[b] = wave_sum((t.x + t.y) + (t.z + t.w));
            const f32x4 u = sh[b][0] * g0 + sh[b][1] * g1 + sh[b][2] * g2 + sh[b][3] * g3; acd[b] = wave_sum((u.x + u.y) + (u.z + u.w)); }
        if (lane == 0) { out[n] = acc[0]; out[pitch + n] = acc[1]; out[2 * pitch + n] = acc[2]; out[3 * pitch + n] = acc[3];
            if (has2) { out[n2] = acd[0]; out[pitch + n2] = acd[1]; out[2 * pitch + n2] = acd[2]; out[3 * pitch + n2] = acd[3]; } }
    }
}
__device__ __forceinline__ void bias_sets(unsigned char* ws, int sel, int gw, int NGW, int lane) {
    const float* MOD = (const float*)(ws + WS_MOD); float* BIAS = (float*)(ws + WS_BIAS);
    const int f = sel;
    bias_rows((const bf16*)(ws + WS_WGU) + (size_t)f * 5632 * 1024, 5632, MOD + (size_t)(f >> 1) * 4 * MODLD + ((f & 1) ? 6 * DM : 0), BIAS + (size_t)f * 4 * 5632, 5632, gw, NGW, lane);
    if (sel == 0) bias_rows((const bf16*)(ws + WS_WHYIN), 2560, MOD + 3 * DM, BIAS + BIAS_IN0, 2560, gw, NGW, lane);
    if (sel == 3) bias_rows((const bf16*)(ws + WS_WSCIN), 3072, MOD + (size_t)4 * MODLD + 3 * DM, BIAS + BIAS_IN1, 3072, gw, NGW, lane);
}
__device__ __forceinline__ void filler(const Args& A, unsigned char* ws, LAS unsigned char* lds, int p, int G) {
    const bool half = (G == 256);
    if (half && (int)blockIdx.x < 128) return;
    int tid_ = threadIdx.x; asm volatile("" : "+v"(tid_)); const int tid = tid_, lane = tid & 63, wid = tid >> 6;
    const int gw = ((int)blockIdx.x - (half ? 128 : 0)) * NWAVES + wid, NGW = (half ? 128 : G) * NWAVES;
    LAS float* scr = (LAS float*)(lds + wid * 16384);
    if (p == 2) convert_items(A, ws, scr, 1, gw, NGW, lane);
    else if (p == 4) { convert_items(A, ws, scr, 2, gw, NGW, lane); bias_sets(ws, 1, gw, NGW, lane); }
    else if (p == 7) { convert_items(A, ws, scr, 3, gw, NGW, lane); bias_sets(ws, 2, gw, NGW, lane); }
    else if (p == 9) { convert_items(A, ws, scr, 4, gw, NGW, lane); bias_sets(ws, 3, gw, NGW, lane); }
}
__device__ __forceinline__ void phase_bias(unsigned char* ws, int G) {
    int tid_ = threadIdx.x; asm volatile("" : "+v"(tid_)); const int tid = tid_, lane = tid & 63, wid = tid >> 6;
    bias_sets(ws, 0, blockIdx.x * NWAVES + wid, G * NWAVES, lane);
}
__device__ __forceinline__ void phase_final_norm(const bf16* xb, float* out, const float* g, const float* ssq, int G) {
    int tid_ = threadIdx.x; asm volatile("" : "+v"(tid_)); const int tid = tid_, lane = tid & 63, wid = tid >> 6;
    const int gw = blockIdx.x * NWAVES + wid, NGW = G * NWAVES;
    f32x4 gv[4];
#pragma unroll
    for (int j = 0; j < 4; ++j) gv[j] = ((const f32x4*)g)[64 * j + lane];
    const bool aff = (G == 256);
    const int mstep = aff ? 256 : NGW; int m = aff ? 2048 * ((int)blockIdx.x & 7) + ((int)blockIdx.x >> 3) * NWAVES + wid : gw;
    int left = aff ? 8 : (gw < TOK ? (TOK - gw + NGW - 1) / NGW : 0);
    if (left == 0) return;
    v2u v[4]; float sq = ssq[m];
#pragma unroll
    for (int j = 0; j < 4; ++j) v[j] = __builtin_nontemporal_load((const v2u*)(xb + (size_t)m * DM) + 64 * j + lane);
    for (;;) {
        const int mn = m + mstep; const bool more = left > 1; const int ml = more ? mn : m; --left;
        v2u nv[4]; const float nsq = ssq[ml];
#pragma unroll
        for (int j = 0; j < 4; ++j) nv[j] = __builtin_nontemporal_load((const v2u*)(xb + (size_t)ml * DM) + 64 * j + lane);
        const float rstd = __builtin_amdgcn_rsqf(sq * (1.0f / DM) + EPS);
        f32x4* xr = (f32x4*)(out + (size_t)m * DM) + lane;
#pragma unroll
        for (int j = 0; j < 4; ++j) { const f32x4 xv = {bflo(v[j].x), bfhi(v[j].x), bflo(v[j].y), bfhi(v[j].y)}; __builtin_nontemporal_store(xv * rstd * gv[j], xr + 64 * j); }
        if (!more) break;
#pragma unroll
        for (int j = 0; j < 4; ++j) v[j] = nv[j];
        sq = nsq; m = mn;
    }
}

__device__ __forceinline__ int sgu_unit_id(bool aff, int bx, int G, int it) {
    const int xx = bx & 7, jj = bx >> 3;
    return aff ? (((xx >> 1) << 8) | ((((xx & 1) * 16 + 4 * (jj >> 3) + it)) << 3) | (jj & 7)) : bx + it * G;
}
__device__ __forceinline__ void sgu_phase(const bf16* P1, bf16* Y, const float* vng, const float* w_s, const float* b_s, LAS unsigned char* lds, int G) {
    int tid_ = threadIdx.x; asm volatile("" : "+v"(tid_)); const int tid = tid_, lane = tid & 63, wid = __builtin_amdgcn_readfirstlane(tid >> 6);
    constexpr int VS = 272, VBUF = 64 * VS, WSL = 2 * VBUF;
    const int sl = tid >> 2, dq = tid & 3;
    const int tb = wid >> 1, db = wid & 1, r = lane & 31, hh = lane >> 5, t = 32 * tb + r, d = 32 * db + r, nkc = 2 * (tb + 1);
    const bool aff = (G == 256); const int bx = blockIdx.x; const int nit = aff ? 4 : (bx < 1024 ? (1024 - bx + G - 1) / G : 0);
    if (nit == 0) return;
    int unit = sgu_unit_id(aff, bx, G, 0);
    v4u r0, r1; v2u uq[4]; float bt;
    { const int hA = unit & 7, chunk = (unit >> 3) & 31, b = unit >> 8; const size_t row0 = (size_t)b * SEQ + chunk * 128;
      const bf16* vp = P1 + (row0 + sl) * 2048 + 512 + hA * 64 + dq * 16; r0 = *(const v4u*)vp; r1 = *(const v4u*)(vp + 8);
#pragma unroll
      for (int g = 0; g < 4; ++g) uq[g] = *(const v2u*)(P1 + (row0 + t) * 2048 + hA * 64 + 32 * db + 8 * g + 4 * hh);
      bt = b_s[hA * 128 + t]; }
    int cur = 0, curh = -1;
    for (int it = 0; it < nit; ++it) {
        unit = sgu_unit_id(aff, bx, G, it);
        const int hA = unit & 7, chunk = (unit >> 3) & 31, b = unit >> 8;
        const size_t row0 = (size_t)b * SEQ + chunk * 128;
        LAS unsigned char* vbuf = lds + cur * VBUF;
        if (hA != curh) {
            if (curh >= 0) __syncthreads();
            const int wr_ = tid >> 2, wq_ = tid & 3; const float* wp = w_s + ((size_t)hA * 128 + wr_) * 128 + 32 * wq_;
            f32x4 wl[8];
#pragma unroll
            for (int q = 0; q < 8; ++q) wl[q] = *(const f32x4*)(wp + 4 * q);
#pragma unroll
            for (int q = 0; q < 4; ++q) { const int s0_ = 32 * wq_ + 8 * q; float wf[8] = {wl[2 * q].x, wl[2 * q].y, wl[2 * q].z, wl[2 * q].w, wl[2 * q + 1].x, wl[2 * q + 1].y, wl[2 * q + 1].z, wl[2 * q + 1].w};
#pragma unroll
                for (int j = 0; j < 8; ++j) wf[j] = (s0_ + j <= wr_) ? wf[j] : 0.f;
                v4u au; au.x = pk2(wf[0], wf[1]); au.y = pk2(wf[2], wf[3]); au.z = pk2(wf[4], wf[5]); au.w = pk2(wf[6], wf[7]);
                *(LAS v4u*)(lds + WSL + wr_ * VS + (s0_ * 2)) = au; }
            curh = hA;
        }
        {
            float f[16];
            f[0] = bflo(r0.x); f[1] = bfhi(r0.x); f[2] = bflo(r0.y); f[3] = bfhi(r0.y); f[4] = bflo(r0.z); f[5] = bfhi(r0.z); f[6] = bflo(r0.w); f[7] = bfhi(r0.w);
            f[8] = bflo(r1.x); f[9] = bfhi(r1.x); f[10] = bflo(r1.y); f[11] = bfhi(r1.y); f[12] = bflo(r1.z); f[13] = bfhi(r1.z); f[14] = bflo(r1.w); f[15] = bfhi(r1.w);
            float ss = 0.f;
#pragma unroll
            for (int i = 0; i < 16; ++i) ss += f[i] * f[i];
            ss += __shfl_xor(ss, 1); ss += __shfl_xor(ss, 2);
            const float rstd = __builtin_amdgcn_rsqf(ss * (1.0f / 64.0f) + EPS);
#pragma unroll
            for (int i = 0; i < 16; ++i) { const int dd = dq * 16 + i; const float y = f[i] * rstd * vng[hA * 64 + dd];
                *(LAS unsigned short*)(vbuf + dd * VS + sl * 2) = (unsigned short)(pk2(y, 0.f) & 0xffffu); }
        }
        const int un = sgu_unit_id(aff, bx, G, (it + 1 < nit) ? it + 1 : it);
        const int hA2 = un & 7, chunk2 = (un >> 3) & 31, b2 = un >> 8; const size_t row2 = (size_t)b2 * SEQ + chunk2 * 128;
        { const bf16* vp = P1 + (row2 + sl) * 2048 + 512 + hA2 * 64 + dq * 16; r0 = *(const v4u*)vp; r1 = *(const v4u*)(vp + 8); }
        __syncthreads();
        f32x16 acc;
#pragma unroll
        for (int i = 0; i < 16; ++i) acc[i] = 0.f;
        const LAS unsigned char* vb = vbuf + d * VS + 16 * hh; const LAS unsigned char* wt = lds + WSL + t * VS + 16 * hh;
#pragma unroll
        for (int kc = 0; kc < 8; ++kc) if (kc < nkc) {
            const bf16x8 wf = *(const LAS bf16x8*)(wt + 32 * kc);
            const bf16x8 vf = *(const LAS bf16x8*)(vb + 32 * kc);
            acc = __builtin_amdgcn_mfma_f32_32x32x16_bf16(vf, wf, acc, 0, 0, 0);
        }
        v2u o[4];
#pragma unroll
        for (int g = 0; g < 4; ++g) { const float y0 = bflo(uq[g].x) * (acc[4 * g] + bt), y1 = bfhi(uq[g].x) * (acc[4 * g + 1] + bt), y2 = bflo(uq[g].y) * (acc[4 * g + 2] + bt), y3 = bfhi(uq[g].y) * (acc[4 * g + 3] + bt);
            o[g].x = pk2(y0, y1); o[g].y = pk2(y2, y3); }
#pragma unroll
        for (int g = 0; g < 4; ++g) uq[g] = *(const v2u*)(P1 + (row2 + t) * 2048 + hA2 * 64 + 32 * db + 8 * g + 4 * hh);
        bt = b_s[hA2 * 128 + t];
#pragma unroll
        for (int g = 0; g < 4; ++g) *(v2u*)(Y + (row0 + t) * 1024 + hA * 64 + 32 * db + 8 * g + 4 * hh) = o[g];
        cur ^= 1;
    }
}

typedef float f32x2 __attribute__((ext_vector_type(2)));
struct SbK { float c0, c1, cm; };
template <int ODD> __device__ __forceinline__ float mul_np(float a, float b, const SbK& k) { return ODD ? __builtin_fmaf(a, b, k.c0) : a * b; }
template <int ODD> __device__ __forceinline__ float inc_np(float e, const SbK& k) { return ODD ? __builtin_fmaf(e, k.c1, 1.0f) : 1.0f + e; }
template <int ODD> __device__ __forceinline__ float omb_np(float be, const SbK& k) { return ODD ? __builtin_fmaf(be, k.cm, 1.0f) : 1.0f - be; }
template <bool MASK> __device__ __forceinline__ void sb_block(const f32x16& sc, int kb0, int t, int hh, float& R, bf16x8& pb0, bf16x8& pb1, const SbK& k) {
    float be[16], om[16];
#pragma unroll
    for (int i = 0; i < 16; i += 2) {
        const float e0 = __builtin_amdgcn_exp2f(sc[i]), e1 = __builtin_amdgcn_exp2f(sc[i + 1]);
        be[i] = __builtin_amdgcn_rcpf(inc_np<0>(e0, k)); be[i + 1] = __builtin_amdgcn_rcpf(inc_np<1>(e1, k));
        om[i] = omb_np<0>(be[i], k); om[i + 1] = omb_np<1>(be[i + 1], k);
    }
    if (MASK) {
#pragma unroll
        for (int i = 0; i < 16; ++i) { const int key = kb0 + 16 * (i >> 3) + 8 * hh + (i & 7); const bool ok = key < t; be[i] = ok ? be[i] : 0.f; om[i] = ok ? om[i] : 1.0f; }
    }
    float ex[16];
    ex[7] = 1.0f; ex[15] = 1.0f;
    ex[6] = om[7]; ex[14] = om[15];
#pragma unroll
    for (int j = 5; j >= 0; --j) { ex[j] = mul_np<0>(ex[j + 1], om[j + 1], k); ex[8 + j] = mul_np<1>(ex[8 + j + 1], om[8 + j + 1], k); }
    const float T0 = mul_np<0>(ex[0], om[0], k), T1 = mul_np<1>(ex[8], om[8], k);
    const float Tp0 = __shfl_xor(T0, 32), Tp1 = __shfl_xor(T1, 32);
    const float P1t = T1 * Tp1, PR = P1t * R;
    const float A0 = (hh == 0 ? Tp0 : 1.0f) * PR, A1 = __builtin_fmaf(hh == 0 ? Tp1 : 1.0f, R, k.c0);
    R = (T0 * Tp0) * PR;
    float w[16];
    w[7] = mul_np<1>(be[7], A0, k); w[15] = mul_np<0>(be[15], A1, k);
#pragma unroll
    for (int j = 0; j < 7; ++j) {
        if (j & 1) { w[j] = mul_np<1>(mul_np<1>(be[j], ex[j], k), A0, k); w[8 + j] = mul_np<0>(mul_np<0>(be[8 + j], ex[8 + j], k), A1, k); }
        else       { w[j] = mul_np<0>(mul_np<0>(be[j], ex[j], k), A0, k); w[8 + j] = mul_np<1>(mul_np<1>(be[8 + j], ex[8 + j], k), A1, k); }
    }
    v4u pu0, pu1;
    pu0.x = pk2(w[0], w[1]); pu0.y = pk2(w[2], w[3]); pu0.z = pk2(w[4], w[5]); pu0.w = pk2(w[6], w[7]);
    pu1.x = pk2(w[8], w[9]); pu1.y = pk2(w[10], w[11]); pu1.z = pk2(w[12], w[13]); pu1.w = pk2(w[14], w[15]);
    pb0 = __builtin_bit_cast(bf16x8, pu0); pb1 = __builtin_bit_cast(bf16x8, pu1);
}
__device__ __forceinline__ void attn_tile(const LAS unsigned char* kbuf, const LAS unsigned char* vbuf, const bf16x8 (&bq)[4], int k0, int q0, int t, int n, int hh, int pin, f32x16& o0, f32x16& o1, float& R, const SbK& sk) {
    constexpr int RS = 144;
    if (k0 < q0 + 31) {
        const bool do1 = (k0 + 32 < q0 + 31);
        const LAS unsigned char* kp = kbuf + pin * RS + hh * 16;
        const LAS unsigned char* vp = vbuf + n * RS + hh * 16;
        const f32x16 z16 = {0.f, 0.f, 0.f, 0.f, 0.f, 0.f, 0.f, 0.f, 0.f, 0.f, 0.f, 0.f, 0.f, 0.f, 0.f, 0.f};
        bf16x8 pb0, pb1;
        if (k0 + 63 < q0) {
            f32x16 s0, s1;
            { const bf16x8 a1 = *(const LAS bf16x8*)(kp + 32 * RS), a0 = *(const LAS bf16x8*)(kp);
              s1 = __builtin_amdgcn_mfma_f32_32x32x16_bf16(a1, bq[0], z16, 0, 0, 0); s0 = __builtin_amdgcn_mfma_f32_32x32x16_bf16(a0, bq[0], z16, 0, 0, 0); }
#pragma unroll
            for (int c = 1; c < 4; ++c) { const bf16x8 a1 = *(const LAS bf16x8*)(kp + 32 * RS + c * 32), a0 = *(const LAS bf16x8*)(kp + c * 32);
                s1 = __builtin_amdgcn_mfma_f32_32x32x16_bf16(a1, bq[c], s1, 0, 0, 0); s0 = __builtin_amdgcn_mfma_f32_32x32x16_bf16(a0, bq[c], s0, 0, 0, 0); }
            sb_block<false>(s1, k0 + 32, t, hh, R, pb0, pb1, sk);
            { const bf16x8 a00 = *(const LAS bf16x8*)(vp + 64), a01 = *(const LAS bf16x8*)(vp + 32 * RS + 64), a10 = *(const LAS bf16x8*)(vp + 96), a11 = *(const LAS bf16x8*)(vp + 32 * RS + 96);
              o0 = __builtin_amdgcn_mfma_f32_32x32x16_bf16(a00, pb0, o0, 0, 0, 0); o1 = __builtin_amdgcn_mfma_f32_32x32x16_bf16(a01, pb0, o1, 0, 0, 0);
              o0 = __builtin_amdgcn_mfma_f32_32x32x16_bf16(a10, pb1, o0, 0, 0, 0); o1 = __builtin_amdgcn_mfma_f32_32x32x16_bf16(a11, pb1, o1, 0, 0, 0); }
            sb_block<false>(s0, k0, t, hh, R, pb0, pb1, sk);
            { const bf16x8 a00 = *(const LAS bf16x8*)(vp), a01 = *(const LAS bf16x8*)(vp + 32 * RS), a10 = *(const LAS bf16x8*)(vp + 32), a11 = *(const LAS bf16x8*)(vp + 32 * RS + 32);
              o0 = __builtin_amdgcn_mfma_f32_32x32x16_bf16(a00, pb0, o0, 0, 0, 0); o1 = __builtin_amdgcn_mfma_f32_32x32x16_bf16(a01, pb0, o1, 0, 0, 0);
              o0 = __builtin_amdgcn_mfma_f32_32x32x16_bf16(a10, pb1, o0, 0, 0, 0); o1 = __builtin_amdgcn_mfma_f32_32x32x16_bf16(a11, pb1, o1, 0, 0, 0); }
        } else {
            asm volatile("" ::: "memory");
            if (do1) {
                f32x16 s1 = __builtin_amdgcn_mfma_f32_32x32x16_bf16(*(const LAS bf16x8*)(kp + 32 * RS), bq[0], z16, 0, 0, 0);
#pragma unroll
                for (int c = 1; c < 4; ++c) s1 = __builtin_amdgcn_mfma_f32_32x32x16_bf16(*(const LAS bf16x8*)(kp + 32 * RS + c * 32), bq[c], s1, 0, 0, 0);
                sb_block<true>(s1, k0 + 32, t, hh, R, pb0, pb1, sk);
                const bf16x8 a00 = *(const LAS bf16x8*)(vp + 64), a01 = *(const LAS bf16x8*)(vp + 32 * RS + 64), a10 = *(const LAS bf16x8*)(vp + 96), a11 = *(const LAS bf16x8*)(vp + 32 * RS + 96);
                o0 = __builtin_amdgcn_mfma_f32_32x32x16_bf16(a00, pb0, o0, 0, 0, 0); o1 = __builtin_amdgcn_mfma_f32_32x32x16_bf16(a01, pb0, o1, 0, 0, 0);
                o0 = __builtin_amdgcn_mfma_f32_32x32x16_bf16(a10, pb1, o0, 0, 0, 0); o1 = __builtin_amdgcn_mfma_f32_32x32x16_bf16(a11, pb1, o1, 0, 0, 0);
            }
            {
                f32x16 s0 = __builtin_amdgcn_mfma_f32_32x32x16_bf16(*(const LAS bf16x8*)(kp), bq[0], z16, 0, 0, 0);
#pragma unroll
                for (int c = 1; c < 4; ++c) s0 = __builtin_amdgcn_mfma_f32_32x32x16_bf16(*(const LAS bf16x8*)(kp + c * 32), bq[c], s0, 0, 0, 0);
                sb_block<true>(s0, k0, t, hh, R, pb0, pb1, sk);
                const bf16x8 a00 = *(const LAS bf16x8*)(vp), a01 = *(const LAS bf16x8*)(vp + 32 * RS), a10 = *(const LAS bf16x8*)(vp + 32), a11 = *(const LAS bf16x8*)(vp + 32 * RS + 32);
                o0 = __builtin_amdgcn_mfma_f32_32x32x16_bf16(a00, pb0, o0, 0, 0, 0); o1 = __builtin_amdgcn_mfma_f32_32x32x16_bf16(a01, pb0, o1, 0, 0, 0);
                o0 = __builtin_amdgcn_mfma_f32_32x32x16_bf16(a10, pb1, o0, 0, 0, 0); o1 = __builtin_amdgcn_mfma_f32_32x32x16_bf16(a11, pb1, o1, 0, 0, 0);
            }
        }
    }
}
__device__ __forceinline__ void attn_unit(const bf16* P1, const bf16* Vt, bf16* Y, int b, int h, int qb, LAS unsigned char* lds) {
    int tid_ = threadIdx.x; asm volatile("" : "+v"(tid_)); const int tid = tid_, lane = tid & 63, wid = __builtin_amdgcn_readfirstlane(tid >> 6);
    const int n = lane & 31, hh = lane >> 5;
    const int Q0 = qb * 256, q0 = Q0 + wid * 32, t = q0 + n;
    const size_t rowbase = (size_t)b * SEQ;
    constexpr int RS = 144, KB_BYTES = 64 * RS, ABUF = 2 * KB_BYTES;
    bf16x8 bq[4];
    { const bf16* qp = P1 + (rowbase + t) * 2048 + 1024 + h * 64 + 8 * hh;
#pragma unroll
      for (int c = 0; c < 4; ++c) bq[c] = *(const bf16x8*)(qp + 16 * c); }
    f32x16 o0, o1;
#pragma unroll
    for (int i = 0; i < 16; ++i) { o0[i] = 0.f; o1[i] = 0.f; }
    float R = 1.0f;
    SbK sk; sk.c0 = 0.0f; sk.c1 = 1.0f; sk.cm = -1.0f; asm volatile("" : "+v"(sk.c0), "+v"(sk.c1), "+v"(sk.cm));
    const int ntiles = (Q0 + 256) / 64;
    const int srow = tid >> 3, sch = tid & 7;
    const bf16* kg = P1 + (rowbase + srow) * 2048 + 1536 + h * 64 + sch * 8;
    const bf16* vg = Vt + (size_t)(h * 64 + srow) * TOK + rowbase + sch * 8;
    const int soff = srow * RS + sch * 16;
    const int pin = (n & 0x13) | ((n & 8) >> 1) | ((n & 4) << 1);
#define KLOAD(kt_) (*(const v4u*)(kg + (size_t)(64 * (kt_)) * 2048))
#define VLOAD(kt_) (*(const v4u*)(vg + 64 * (kt_)))
    v4u kA = KLOAD(ntiles - 1), vA = VLOAD(ntiles - 1);
    v4u kB = KLOAD(ntiles - 2), vB = VLOAD(ntiles - 2);
    *(LAS v4u*)(lds + soff) = kA; *(LAS v4u*)(lds + KB_BYTES + soff) = vA;
    __syncthreads();
    LAS unsigned* flags = (LAS unsigned*)(lds + 2 * ABUF);
    bool alive = true;
    for (int kt = ntiles - 1; kt >= 0; kt -= 2) {
        { const int kp2 = kt >= 2 ? kt - 2 : 0; kA = KLOAD(kp2); vA = VLOAD(kp2); }
        if (alive) { attn_tile(lds, lds + KB_BYTES, bq, kt * 64, q0, t, n, hh, pin, o0, o1, R, sk); alive = __builtin_amdgcn_ballot_w64(R != 0.0f) != 0ull; }
        if (lane == 0) flags[wid] = alive ? 1u : 0u;
        *(LAS v4u*)(lds + ABUF + soff) = kB; *(LAS v4u*)(lds + ABUF + KB_BYTES + soff) = vB;
        __syncthreads();
        if (__builtin_amdgcn_ballot_w64(flags[lane & 7] != 0u) == 0ull) break;
        { const int kp3 = kt >= 3 ? kt - 3 : 0; kB = KLOAD(kp3); vB = VLOAD(kp3); }
        if (alive) { attn_tile(lds + ABUF, lds + ABUF + KB_BYTES, bq, (kt - 1) * 64, q0, t, n, hh, pin, o0, o1, R, sk); alive = __builtin_amdgcn_ballot_w64(R != 0.0f) != 0ull; }
        if (lane == 0) flags[8 + wid] = alive ? 1u : 0u;
        if (kt >= 2) { *(LAS v4u*)(lds + soff) = kA; *(LAS v4u*)(lds + KB_BYTES + soff) = vA; }
        __syncthreads();
        if (__builtin_amdgcn_ballot_w64(flags[8 + (lane & 7)] != 0u) == 0ull) break;
    }
    __syncthreads();
#undef KLOAD
#undef VLOAD
    bf16* yp = Y + (rowbase + t) * 1024 + 512 + h * 64 + 4 * hh;
#pragma unroll
    for (int g = 0; g < 4; ++g) {
        v2u w0; w0.x = pk2(o0[4 * g], o0[4 * g + 1]); w0.y = pk2(o0[4 * g + 2], o0[4 * g + 3]);
        v2u w1; w1.x = pk2(o1[4 * g], o1[4 * g + 1]); w1.y = pk2(o1[4 * g + 2], o1[4 * g + 3]);
        *(v2u*)(yp + 8 * g) = w0; *(v2u*)(yp + 32 + 8 * g) = w1;
    }
}

__device__ __forceinline__ void phase_mixer0(const Args& A, LAS unsigned char* lds, int G) {
    const bf16* P1 = (const bf16*)(A.ws + WS_R1); const bf16* Vt = (const bf16*)(A.ws + WS_VT); bf16* Y = (bf16*)(A.ws + WS_H);
    for (int p = blockIdx.x; p < 256; p += G) {
        const int x = p & 7, i = p >> 3, b = x >> 1, h = i >> 2, jq = i & 3, qb0 = 8 * (x & 1);
        attn_unit(P1, Vt, Y, b, h, qb0 + 7 - jq, lds);
        attn_unit(P1, Vt, Y, b, h, qb0 + jq, lds);
    }
    __syncthreads();
    sgu_phase(P1, Y, A.in[10], A.in[11], A.in[12], lds, G);
}

__device__ __forceinline__ void phase_conv(const Args& A, int G) {
    const bf16* PS = (const bf16*)(A.ws + WS_R1); bf16* Y = (bf16*)(A.ws + WS_H); const float* cw = A.in[14];
    int tid_ = threadIdx.x; asm volatile("" : "+v"(tid_)); const int tid = tid_, cgp = tid & 127, sub = tid >> 7, ch0 = cgp * 8;
    float w0[8], w1[8], w2[8];
#pragma unroll
    for (int i = 0; i < 8; ++i) { w0[i] = cw[ch0 + i]; w1[i] = cw[1024 + ch0 + i]; w2[i] = cw[2048 + ch0 + i]; }
    const bool aff = (G == 256); const int cbx = blockIdx.x; const int cnit = aff ? 2 : (cbx < TOK / 32 ? (TOK / 32 - cbx + G - 1) / G : 0);
    for (int cit = 0; cit < cnit; ++cit) { const int unit = aff ? 64 * (cbx & 7) + 2 * (cbx >> 3) + cit : cbx + cit * G;
        const int r0 = unit * 32 + sub * 8; const bool halo = (r0 & (SEQ - 1)) != 0;
        float pm2[8], pm1[8];
#pragma unroll
        for (int i = 0; i < 8; ++i) { pm2[i] = 0.f; pm1[i] = 0.f; }
        if (halo) {
            const v4u c2 = *(const v4u*)(PS + (size_t)(r0 - 2) * 3072 + 1024 + ch0), x2 = *(const v4u*)(PS + (size_t)(r0 - 2) * 3072 + 2048 + ch0);
            const v4u c1 = *(const v4u*)(PS + (size_t)(r0 - 1) * 3072 + 1024 + ch0), x1 = *(const v4u*)(PS + (size_t)(r0 - 1) * 3072 + 2048 + ch0);
            pm2[0] = bflo(c2.x) * bflo(x2.x); pm2[1] = bfhi(c2.x) * bfhi(x2.x); pm2[2] = bflo(c2.y) * bflo(x2.y); pm2[3] = bfhi(c2.y) * bfhi(x2.y);
            pm2[4] = bflo(c2.z) * bflo(x2.z); pm2[5] = bfhi(c2.z) * bfhi(x2.z); pm2[6] = bflo(c2.w) * bflo(x2.w); pm2[7] = bfhi(c2.w) * bfhi(x2.w);
            pm1[0] = bflo(c1.x) * bflo(x1.x); pm1[1] = bfhi(c1.x) * bfhi(x1.x); pm1[2] = bflo(c1.y) * bflo(x1.y); pm1[3] = bfhi(c1.y) * bfhi(x1.y);
            pm1[4] = bflo(c1.z) * bflo(x1.z); pm1[5] = bfhi(c1.z) * bfhi(x1.z); pm1[6] = bflo(c1.w) * bflo(x1.w); pm1[7] = bfhi(c1.w) * bfhi(x1.w);
        }
        v4u bgv[8], cgv8[8], xv8[8];
#pragma unroll
        for (int i = 0; i < 8; ++i) { const bf16* rp = PS + (size_t)(r0 + i) * 3072 + ch0; bgv[i] = __builtin_nontemporal_load((const v4u*)rp); cgv8[i] = __builtin_nontemporal_load((const v4u*)(rp + 1024)); xv8[i] = __builtin_nontemporal_load((const v4u*)(rp + 2048)); }
#pragma unroll
        for (int i = 0; i < 8; ++i) {
            const v4u bg = bgv[i], cgv = cgv8[i], xv = xv8[i];
            float p[8], bgf[8], y[8];
            p[0] = bflo(cgv.x) * bflo(xv.x); p[1] = bfhi(cgv.x) * bfhi(xv.x); p[2] = bflo(cgv.y) * bflo(xv.y); p[3] = bfhi(cgv.y) * bfhi(xv.y);
            p[4] = bflo(cgv.z) * bflo(xv.z); p[5] = bfhi(cgv.z) * bfhi(xv.z); p[6] = bflo(cgv.w) * bflo(xv.w); p[7] = bfhi(cgv.w) * bfhi(xv.w);
            bgf[0] = bflo(bg.x); bgf[1] = bfhi(bg.x); bgf[2] = bflo(bg.y); bgf[3] = bfhi(bg.y); bgf[4] = bflo(bg.z); bgf[5] = bfhi(bg.z); bgf[6] = bflo(bg.w); bgf[7] = bfhi(bg.w);
#pragma unroll
            for (int c = 0; c < 8; ++c) { y[c] = bgf[c] * (w0[c] * pm2[c] + w1[c] * pm1[c] + w2[c] * p[c]); pm2[c] = pm1[c]; pm1[c] = p[c]; }
            v4u o; o.x = pk2(y[0], y[1]); o.y = pk2(y[2], y[3]); o.z = pk2(y[4], y[5]); o.w = pk2(y[6], y[7]);
            *(v4u*)(Y + (size_t)(r0 + i) * 1024 + ch0) = o;
        }
    }
}

constexpr int N_PHASES = 17;
__global__ void __launch_bounds__(NTHR, 2) mega_fwd(Args A) {
    extern __shared__ __attribute__((aligned(16))) unsigned char lds_raw[];
    LAS unsigned char* lds = (LAS unsigned char*)lds_raw;
    cg::grid_group grid = cg::this_grid();
    const int G = gridDim.x;
    volatile LAS unsigned* bst = (volatile LAS unsigned*)(lds + 131072);
    if (threadIdx.x < 2) bst[threadIdx.x] = 0u;
    __syncthreads();
    XcdBarrier xbar = xcd_barrier_post((unsigned*)(A.ws + WS_BAR), bst);
    if (A.hi > 1000) grid.sync();
    for (int p = A.lo; p < A.hi; ++p) {
      for (int rep = 0; rep <= (((PROBE_MASK >> p) & 1) ? PROBE_N : 0); ++rep) {
        if (rep) __syncthreads();
        size_t zoff = 0; asm volatile("" : "+s"(zoff));
        unsigned char* ws = A.ws + zoff;
        float* X = A.out + zoff;
        const float* MOD = (const float*)(ws + WS_MOD);
        float* SSQ = (float*)(ws + WS_SSQ);
        const float* BIAS = (const float*)(ws + WS_BIAS);
        bf16* HA = (bf16*)(ws + WS_H); bf16* HB = (bf16*)(ws + WS_HB); bf16* XB = (bf16*)(ws + WS_XB);
        if (p == 0) phase_prologue(A, lds, G);
        else if (p == 1) { phase_norm0(A.in[0], A.in[4], MOD + DM, HA, XB, SSQ, G); phase_bias(ws, G); }
        else if (p == 16) phase_final_norm(XB, X, A.in[16], SSQ + 6 * TOK, G);
        else {
            const int q = p - 2, L = q / 7, r = q % 7, s = (r < 2) ? 0 : (r < 5 ? 1 : 2), j = L * 3 + s;
            const float* modL = MOD + (size_t)L * 4 * MODLD;
            const float* ssqj = SSQ + (size_t)j * TOK;
            if (r == 0 || r == 5) {
                const int f = L * 2 + (s >> 1);
                pg8::Gemm g{r == 5 ? HB : HA, (const bf16*)(ws + WS_WGU) + (size_t)f * 5632 * 1024, TOK, 5632, DM}; pg8::StaticOrder S; S.init(TOK, 5632, G, (int)blockIdx.x);
                pg8::EpiSwiGLU E{(bf16*)(ws + WS_R1), FF, ssqj, BIAS + (size_t)f * 4 * 5632};
                pg8::gemm_phase<pg8::EpiSwiGLU, pg8::StaticOrder, true, true>(lds, g, S, E);
                if (!rep) filler(A, ws, lds, p, G);
            } else if (r == 2) {
                {
                    const int N = (L == 0) ? 2048 : 3072;
                    const pg8::Gemm g{HA, (const bf16*)(ws + (L == 0 ? WS_WHYIN : WS_WSCIN)), TOK, N, DM};
                    const pg8::EpiBf16G<false> E{(bf16*)(ws + WS_R1), N, (L == 0) ? 4 : 0, ssqj, BIAS + (L == 0 ? BIAS_IN0 : BIAS_IN1), (L == 0) ? 2560 : 3072};
                    pg8::StaticOrder S; S.init(g.M, g.N, G, (int)blockIdx.x);
                    pg8::gemm_phase<pg8::EpiBf16G<false>, pg8::StaticOrder, true, true>(lds, g, S, E);
                }
                if (L == 0) {
                    pg8::Gemm g{(const bf16*)(ws + WS_WHYIN) + (size_t)2048 * 1024, HA, 512, TOK, DM}; pg8::StaticOrder S; S.init(512, TOK, G, (int)blockIdx.x);
                    pg8::EpiBf16G<true> E{(bf16*)(ws + WS_VT), TOK, 0, ssqj, BIAS + BIAS_IN0 + 2048, 2560};
                    pg8::gemm_phase<pg8::EpiBf16G<true>, pg8::StaticOrder, true, true>(lds, g, S, E);
                    if (!rep) filler(A, ws, lds, p, G);
                }
            } else if (r == 3) {
                if (L == 0) phase_mixer0(A, lds, G); else phase_conv(A, G);
            } else {
                const int jn = j + 1, jc = jn > 5 ? 5 : jn, Ln = jc / 3, sn = jc % 3;
                const float* gn = A.in[4] + (size_t)jc * DM; const int goff = L * 4 * MODLD + (3 * s + 2) * DM, soff = Ln * 4 * MODLD + (3 * sn + 1) * DM;
                float* ssqn = SSQ + (size_t)jn * TOK;
                const bool dn = (s != 1); const int f = L * 2 + (s >> 1);
                const bf16* Ap = dn ? (const bf16*)(ws + WS_R1) : HA;
                const bf16* Bp = dn ? (const bf16*)(ws + WS_WD) + (size_t)f * 1024 * FF : (const bf16*)(ws + (L == 0 ? WS_WHYOUT : WS_WSCOUT));
                const pg8::Gemm g{Ap, Bp, TOK, DM, dn ? FF : DM};
                const pg8::EpiResid E{XB, XB, MOD, rep ? -98304 : goff, soff, dn ? HA : HB, gn, rep ? SSQ + 7 * TOK : ssqn};
                pg8::StaticOrder S; S.init(TOK, DM, G, (int)blockIdx.x);
                pg8::gemm_phase<pg8::EpiResid, pg8::StaticOrder, true, true>(lds, g, S, E);
            }
        }
      }
        if (p + 1 < A.hi) xcd_barrier(xbar);
    }
}

extern "C" void kernel_launch(void* const* d_in, const int* in_sizes, int n_in, void* d_out, int out_size, void* d_ws, size_t ws_size, hipStream_t stream) {
    static int grid = 0;
    if (grid == 0) {
        if (n_in != 17 || out_size != TOK * DM || ws_size < WS_END) { fprintf(stderr, "kernel_launch: unexpected shapes (n_in %d out %d ws %zu)\n", n_in, out_size, ws_size); grid = -1; return; }
        int dev = 0, cus = 0, per_cu = 0;
        (void)hipGetDevice(&dev); (void)hipDeviceGetAttribute(&cus, hipDeviceAttributeMultiprocessorCount, dev);
        if (hipFuncSetAttribute((const void*)mega_fwd, hipFuncAttributeMaxDynamicSharedMemorySize, LDS_BYTES) != hipSuccess) { fprintf(stderr, "kernel_launch: hipFuncSetAttribute failed\n"); grid = -1; return; }
        if (hipOccupancyMaxActiveBlocksPerMultiprocessor(&per_cu, (const void*)mega_fwd, NTHR, LDS_BYTES) != hipSuccess || per_cu < 1) { fprintf(stderr, "kernel_launch: occupancy query gave %d\n", per_cu); per_cu = 1; }
        (void)hipGetLastError();
        grid = cus * 1;
    }
    if (grid < 0) return;
    if (hipMemsetAsync(d_ws, 0, CTL_ZERO_BYTES, stream) != hipSuccess) { fprintf(stderr, "kernel_launch: memset failed\n"); return; }
    Args a{};
    for (int i = 0; i < 17; ++i) a.in[i] = (const float*)d_in[i];
    a.out = (float*)d_out; a.ws = (unsigned char*)d_ws;
    a.lo = 0; a.hi = N_PHASES; void* kargs[] = {&a};
    hipError_t e = hipLaunchCooperativeKernel((const void*)mega_fwd, dim3(grid), dim3(NTHR), kargs, LDS_BYTES, stream);
    if (e != hipSuccess) fprintf(stderr, "cooperative launch failed: %s (grid %d)\n", hipGetErrorString(e), grid);
}
```
